# Optimizing an MI355X kernel written in HIP

```python
import math
import jax, jax.numpy as jnp
from jax import lax
import numpy as np

D_MODEL = 1024
BATCH = 8
SEQ = 4096
DEPTH = 2

N_MIXERS = 2
EPS = 1e-6
BLOCK = 128
SWA_HEADS = 16
SWA_KV_HEADS = 2
SWA_HEAD_DIM = 64
WINDOW = 128
SWA_GROUP = SWA_HEADS // SWA_KV_HEADS
SWA_QKV_DIM = (SWA_HEADS + 2 * SWA_KV_HEADS) * SWA_HEAD_DIM
DIFF_HEADS = 8
DIFF_HEAD_DIM = 64
DIFF_QKV_DIM = 3 * DIFF_HEADS * 2 * DIFF_HEAD_DIM
D_FF = 2816
CONV_WIDTH = 3

N_A_LAYERS = (DEPTH + 1) // 2
N_B_LAYERS = DEPTH // 2

kernel_name = "hybrid_swa_sink_diffattn_alibi_convffn"


def rmsnorm(x, g):
    xf = x.astype(jnp.float32)
    y = xf * lax.rsqrt(jnp.mean(xf * xf, axis=-1, keepdims=True) + EPS)
    return (y * g.astype(jnp.float32)).astype(x.dtype)


def alibi_slopes(n_heads):
    return jnp.exp2(-8.0 * (jnp.arange(n_heads, dtype=jnp.float32) + 1.0) / n_heads)


def diff_lambda_init(layer_idx):
    return 0.8 - 0.6 * math.exp(-0.3 * layer_idx)


def sliding_window_attention(h, w_qkv, sinks, w_o):
    B, S, _ = h.shape
    nb = S // BLOCK
    qkv = h @ w_qkv
    q, k, v = jnp.split(qkv, [SWA_HEADS * SWA_HEAD_DIM,
                              (SWA_HEADS + SWA_KV_HEADS) * SWA_HEAD_DIM], axis=-1)
    q = q.reshape(B, nb, BLOCK, SWA_KV_HEADS, SWA_GROUP, SWA_HEAD_DIM)
    k = k.reshape(B, nb, BLOCK, SWA_KV_HEADS, SWA_HEAD_DIM)
    v = v.reshape(B, nb, BLOCK, SWA_KV_HEADS, SWA_HEAD_DIM)

    def with_prev(t):
        prev = jnp.pad(t[:, :-1], ((0, 0), (1, 0), (0, 0), (0, 0), (0, 0)))
        return jnp.concatenate([prev, t], axis=2)

    kb, vb = with_prev(k), with_prev(v)
    scale = SWA_HEAD_DIM ** -0.5
    scores = jnp.einsum('bnqkgd,bnskd->bnkgqs', q, kb).astype(jnp.float32) * scale
    qi = jnp.arange(BLOCK)[:, None]
    kj = jnp.arange(2 * BLOCK)[None, :]
    dist = qi + BLOCK - kj
    kpos = jnp.arange(nb)[:, None, None] * BLOCK - BLOCK + kj[None]
    valid = (dist >= 0)[None] & (dist < WINDOW)[None] & (kpos >= 0)
    slopes = alibi_slopes(SWA_HEADS).reshape(SWA_KV_HEADS, SWA_GROUP)
    bias = -slopes[:, :, None, None] * dist.astype(jnp.float32)
    scores = jnp.where(valid[None, :, None, None], scores + bias[None, None], -jnp.inf)
    sink = sinks.astype(jnp.float32).reshape(SWA_KV_HEADS, SWA_GROUP)[None, None, :, :, None, None]
    sink = jnp.broadcast_to(sink, scores.shape[:-1] + (1,))
    probs = jax.nn.softmax(jnp.concatenate([scores, sink], axis=-1), axis=-1)[..., :-1]
    out = jnp.einsum('bnkgqs,bnskd->bnqkgd', probs.astype(vb.dtype), vb)
    return out.reshape(B, S, SWA_HEADS * SWA_HEAD_DIM) @ w_o


def differential_attention(h, w_qkv, lam_q1, lam_k1, lam_q2, lam_k2, subln_g, w_o, lambda_init):
    B, S, _ = h.shape
    H, d = DIFF_HEADS, DIFF_HEAD_DIM
    nqb = S // BLOCK
    qkv = h @ w_qkv
    q, k, v = jnp.split(qkv, 3, axis=-1)
    q = q.reshape(B, S, H, 2, d)
    k = k.reshape(B, S, H, 2, d)
    v = v.reshape(B, S, H, 2 * d)
    lam = (jnp.exp(jnp.sum(lam_q1.astype(jnp.float32) * lam_k1.astype(jnp.float32)))
           - jnp.exp(jnp.sum(lam_q2.astype(jnp.float32) * lam_k2.astype(jnp.float32)))
           + lambda_init)
    slopes = alibi_slopes(H)[:, None, None, None]
    scale = d ** -0.5
    kpos = jnp.arange(S)
    qb = jnp.moveaxis(q.reshape(B, nqb, BLOCK, H, 2, d), 1, 0)

    def query_block(args):
        q_blk, n = args
        s = jnp.einsum('bqhcd,bshcd->bhcqs', q_blk, k).astype(jnp.float32) * scale
        qpos = n * BLOCK + jnp.arange(BLOCK)
        dist = (qpos[:, None] - kpos[None, :])
        s = jnp.where(dist >= 0, s - slopes * dist.astype(jnp.float32), -jnp.inf)
        p = jax.nn.softmax(s, axis=-1)
        a = p[:, :, 0] - lam * p[:, :, 1]
        return jnp.einsum('bhqs,bshe->bqhe', a.astype(v.dtype), v)

    o = lax.map(query_block, (qb, jnp.arange(nqb)))
    o = jnp.moveaxis(o, 0, 1).reshape(B, S, H, 2 * d)
    o = rmsnorm(o, subln_g) * (1.0 - lambda_init)
    return o.reshape(B, S, H * 2 * d) @ w_o


def conv_ffn(h, w_up, conv_w, conv_b, w_down):
    S = h.shape[1]
    u = h @ w_up
    up = jnp.pad(u, ((0, 0), (CONV_WIDTH - 1, 0), (0, 0)))
    c = conv_b
    for tap in range(CONV_WIDTH):
        c = c + conv_w[tap] * up[:, tap:tap + S]
    g, val = jnp.split(c, 2, axis=-1)
    return (jax.nn.gelu(g, approximate=True) * val) @ w_down


def setup_inputs(seed: int = 0) -> dict:
    key = jax.random.key(seed)
    ks = jax.random.split(key, 24)
    f32 = jnp.float32

    def nrm(k, shape, scale):
        return jax.random.normal(k, shape, f32) * scale

    def gain(k, shape):
        return 1.0 + 0.02 * jax.random.normal(k, shape, f32)

    return {
        "x": jax.random.normal(ks[0], (BATCH, SEQ, D_MODEL), f32),
        "mix_pre_g": gain(ks[1], (DEPTH, D_MODEL)),
        "mix_post_g": gain(ks[2], (DEPTH, D_MODEL)),
        "ffn_pre_g": gain(ks[3], (DEPTH, D_MODEL)),
        "ffn_post_g": gain(ks[4], (DEPTH, D_MODEL)),
        "swa_w_qkv": nrm(ks[5], (N_A_LAYERS, D_MODEL, SWA_QKV_DIM), D_MODEL ** -0.5),
        "swa_sinks": nrm(ks[6], (N_A_LAYERS, SWA_HEADS), 1.0),
        "swa_w_o": nrm(ks[7], (N_A_LAYERS, SWA_HEADS * SWA_HEAD_DIM, D_MODEL),
                        (SWA_HEADS * SWA_HEAD_DIM) ** -0.5),
        "diff_w_qkv": nrm(ks[8], (N_B_LAYERS, D_MODEL, DIFF_QKV_DIM), D_MODEL ** -0.5),
        "diff_lam_q1": nrm(ks[9], (N_B_LAYERS, DIFF_HEAD_DIM), 0.1),
        "diff_lam_k1": nrm(ks[10], (N_B_LAYERS, DIFF_HEAD_DIM), 0.1),
        "diff_lam_q2": nrm(ks[11], (N_B_LAYERS, DIFF_HEAD_DIM), 0.1),
        "diff_lam_k2": nrm(ks[12], (N_B_LAYERS, DIFF_HEAD_DIM), 0.1),
        "diff_subln_g": gain(ks[13], (N_B_LAYERS, 2 * DIFF_HEAD_DIM)),
        "diff_w_o": nrm(ks[14], (N_B_LAYERS, DIFF_HEADS * 2 * DIFF_HEAD_DIM, D_MODEL),
                         (DIFF_HEADS * 2 * DIFF_HEAD_DIM) ** -0.5),
        "ffn_w_up": nrm(ks[15], (DEPTH, D_MODEL, 2 * D_FF), D_MODEL ** -0.5),
        "ffn_conv_w": nrm(ks[16], (DEPTH, CONV_WIDTH, 2 * D_FF), CONV_WIDTH ** -0.5),
        "ffn_conv_b": nrm(ks[17], (DEPTH, 2 * D_FF), 0.01),
        "ffn_w_down": nrm(ks[18], (DEPTH, D_FF, D_MODEL), D_FF ** -0.5),
    }


def reference(x, mix_pre_g, mix_post_g, ffn_pre_g, ffn_post_g,
              swa_w_qkv, swa_sinks, swa_w_o,
              diff_w_qkv, diff_lam_q1, diff_lam_k1, diff_lam_q2, diff_lam_k2,
              diff_subln_g, diff_w_o,
              ffn_w_up, ffn_conv_w, ffn_conv_b, ffn_w_down):
    for i in range(DEPTH):
        h = rmsnorm(x, mix_pre_g[i])
        j = i // N_MIXERS
        if i % N_MIXERS == 0:
            m = sliding_window_attention(h, swa_w_qkv[j], swa_sinks[j], swa_w_o[j])
        else:
            m = differential_attention(h, diff_w_qkv[j], diff_lam_q1[j], diff_lam_k1[j],
                                       diff_lam_q2[j], diff_lam_k2[j], diff_subln_g[j],
                                       diff_w_o[j], diff_lambda_init(i))
        x = x + rmsnorm(m, mix_post_g[i])
        h = rmsnorm(x, ffn_pre_g[i])
        f = conv_ffn(h, ffn_w_up[i], ffn_conv_w[i], ffn_conv_b[i], ffn_w_down[i])
        x = x + rmsnorm(f, ffn_post_g[i])
    return x
```

```cpp
#include <hip/hip_runtime.h>
#include <hip/hip_cooperative_groups.h>
#include <cstdio>
#include <cstdint>
namespace cg = cooperative_groups;
namespace pg8 {
#define PG8_LAS __attribute__((address_space(3)))
typedef unsigned short bf16_t;
typedef short bf16x8 __attribute__((ext_vector_type(8)));
typedef float f32x4 __attribute__((ext_vector_type(4)));
typedef unsigned u32x4 __attribute__((ext_vector_type(4)));
constexpr int BM = 256, BK = 64, HALF = 128, HTB = HALF * BK * 2  , STAGE_BYTES = 8 * HTB, NXCD = 8, WGM = 8;

__host__ __device__ __forceinline__ int lds_byte(int r, int c) { const int st = (r >> 4) * 2 + (c >> 5), rr = r & 15, cc = c & 31, ob = rr * 64 + cc * 2; return st * 1024 + (ob ^ (((ob >> 9) & 1) << 5)); }
__host__ __device__ __forceinline__ void stage_rc(int b, int& R, int& C) { const int st = b / 1024, sb = b % 1024, swz = sb ^ (((sb >> 9) & 1) << 5); R = (st >> 1) * 16 + swz / 64; C = (st & 1) * 32 + (swz % 64) / 2; }
__host__ __device__ __forceinline__ int perm32(int rho) { const int n = rho >> 4, i = rho & 15; return 8 * (i >> 2) + 4 * n + (i & 3); }

struct Unit { int pm, pn; };
struct Gemm { const bf16_t* A; const bf16_t* Bt; int M, N, K; };

struct StaticOrder {
    int nM, nN, nwg, G, c;
    __host__ __device__ void init(int M, int N, int G_, int c_) { nM = M / BM; nN = N / BM; nwg = nM * nN; G = G_; c = c_; }
    __host__ __device__ bool next(int i, Unit& u) const {
        const long L = (long)i * G + c; if (L >= nwg) return false;
        int wgid = (int)L; { const int q = nwg / NXCD, r = nwg % NXCD, xcd = wgid % NXCD, off = wgid / NXCD; wgid = (xcd < r ? xcd * (q + 1) : r * (q + 1) + (xcd - r) * q) + off; }
        const int nig = WGM * nN, gid = wgid / nig, fm = gid * WGM, gsz = (nM - fm) < WGM ? (nM - fm) : WGM;
        u.pm = fm + ((wgid % nig) % gsz); u.pn = (wgid % nig) / gsz; return true;
    }
    __device__ __forceinline__ void a_ready(const Unit&) const {}
    __device__ __forceinline__ void done(const Unit&) const {}
};

__device__ __forceinline__ unsigned cvt_pk_bf16(float lo, float hi) { unsigned r; asm volatile("v_cvt_pk_bf16_f32 %0, %1, %2" : "=v"(r) : "v"(lo), "v"(hi)); return r; }
typedef float f32x2 __attribute__((ext_vector_type(2)));
__device__ __forceinline__ f32x2 gelu_pk(f32x2 v) {
    const f32x2 av = __builtin_elementwise_abs(v), d = av * 0.2316418882f + 1.0f;
    f32x2 t; t.x = __builtin_amdgcn_rcpf(d.x); t.y = __builtin_amdgcn_rcpf(d.y);
    f32x2 q = t * 0.5307027145f + (-0.7265760135f); q = q * t + 0.7107068705f; q = q * t + (-0.142248368f); q = q * t + 0.127414796f; q = q * t;
    const f32x2 s = (v * v) * (-0.72134752044f);
    f32x2 e; e.x = __builtin_amdgcn_exp2f(s.x); e.y = __builtin_amdgcn_exp2f(s.y);
    const f32x2 m = v * (q * e), r = v - m;
    f32x2 o; o.x = v.x < 0.f ? m.x : r.x; o.y = v.y < 0.f ? m.y : r.y; return o;
}

template <int ACT  > struct EpiBf16 {
    static constexpr bool PERM = true, AFTER_DRAIN = false; static_assert(ACT == 0 || ACT == 1, "EpiBf16: ACT is 0 (none) or 1 (gelu_pk)");
    bf16_t* O; int ldc; const float* bias; int split_cols; size_t split_stride; float scale0;
    __device__ __forceinline__ void operator()(const f32x4 (&acc)[2][2][4][2], const Unit& u, int wr, int wc, int fr, int fq) const {
        const int row0 = u.pm * BM + wr * 64 + fr; int colt = u.pn * BM; bf16_t* base = O;
        float sc = 1.f; if (split_cols) { const int t = colt / split_cols; base += (size_t)t * split_stride; colt -= t * split_cols; if (t == 0) sc = scale0; }
        const int col0 = colt + wc * 32 + 8 * fq, bcol0 = u.pn * BM + wc * 32 + 8 * fq;
        f32x4 bv[2][2];
#pragma unroll
        for (int bj = 0; bj < 2; ++bj)
#pragma unroll
            for (int n = 0; n < 2; ++n) bv[bj][n] = bias ? *(const f32x4*)(bias + bcol0 + bj * HALF + 4 * n) : (f32x4){0.f, 0.f, 0.f, 0.f};
#pragma unroll
        for (int ai = 0; ai < 2; ++ai)
#pragma unroll
            for (int m = 0; m < 4; ++m) { bf16_t* rowp = base + (size_t)(row0 + ai * HALF + m * 16) * ldc + col0;
#pragma unroll
                for (int bj = 0; bj < 2; ++bj) { f32x4 v0 = acc[ai][bj][m][0] + bv[bj][0], v1 = acc[ai][bj][m][1] + bv[bj][1];
                    if (ACT == 1) { f32x2 a = gelu_pk((f32x2){v0[0], v0[1]}), b = gelu_pk((f32x2){v0[2], v0[3]}), c = gelu_pk((f32x2){v1[0], v1[1]}), d = gelu_pk((f32x2){v1[2], v1[3]});
                        v0 = (f32x4){a.x, a.y, b.x, b.y}; v1 = (f32x4){c.x, c.y, d.x, d.y}; }
                    v0 = v0 * sc; v1 = v1 * sc; u32x4 w; w.x = cvt_pk_bf16(v0[0], v0[1]); w.y = cvt_pk_bf16(v0[2], v0[3]); w.z = cvt_pk_bf16(v1[0], v1[1]); w.w = cvt_pk_bf16(v1[2], v1[3]);
                    *(u32x4*)(rowp + bj * HALF) = w; } }
    }
};
template <class Epi, class Sched, bool ALIGN_EPI = false, bool SP2 = false>
__device__ __forceinline__ void gemm_phase(PG8_LAS unsigned char* lds, const Gemm g, const Sched& S, const Epi& E) {
    const int tid = threadIdx.x, wid = __builtin_amdgcn_readfirstlane(tid >> 6), lane = tid & 63, wr = wid >> 2, wc = wid & 3, fr = lane & 15, fq = lane >> 4;
    const int K = g.K, nt = K / BK;
    unsigned voffA[2], voffB[2];
#pragma unroll
    for (int i = 0; i < 2; ++i) { int R, C; stage_rc(tid * 16 + i * 8192, R, C); const int Rb = Epi::PERM ? ((R & ~31) + perm32(R & 31)) : R;
        voffA[i] = (unsigned)(R * K + C) * 2u; voffB[i] = (unsigned)(Rb * K + C) * 2u; }
    const size_t kstep = (size_t)(BK * 2);
    const size_t hstep = (size_t)HALF * K * 2;
    const size_t tstep = 2 * hstep;
    const unsigned ldsw = (unsigned)wid * 1024u;
    const int aoff = lds_byte(wr * 64 + fr, fq * 8), boff = lds_byte(wc * 32 + fr, fq * 8);
#define PG8_SA(b, h) (((b) * 2 + (h)) * HTB)
#define PG8_SB(b, h) ((4 + (b) * 2 + (h)) * HTB)
#define PG8_STAGE(bufoff, gbase, voff) do { _Pragma("unroll") for (int _i = 0; _i < 2; ++_i) \
        __builtin_amdgcn_global_load_lds((const unsigned*)((const char*)(gbase) + (voff)[_i]), (PG8_LAS unsigned*)(lds + (bufoff) + ldsw + _i * 8192), 16, 0, 0); } while (0)
#define PG8_LDA(dst, b, h) do { _Pragma("unroll") for (int m = 0; m < 4; ++m) _Pragma("unroll") for (int k = 0; k < 2; ++k) dst[m][k] = *(const PG8_LAS bf16x8*)(lds + PG8_SA(b, h) + aoff + m * 2048 + k * 1024); } while (0)
#define PG8_LDB(dst, b, h) do { _Pragma("unroll") for (int n = 0; n < 2; ++n) _Pragma("unroll") for (int k = 0; k < 2; ++k) dst[n][k] = *(const PG8_LAS bf16x8*)(lds + PG8_SB(b, h) + boff + n * 2048 + k * 1024); } while (0)
#define PG8_MMA(ai, bj, At, Bt) do { __builtin_amdgcn_s_setprio(1); _Pragma("unroll") for (int m = 0; m < 4; ++m) _Pragma("unroll") for (int n = 0; n < 2; ++n) _Pragma("unroll") for (int k = 0; k < 2; ++k) \
        acc[ai][bj][m][n] = __builtin_amdgcn_mfma_f32_16x16x32_bf16(Bt[n][k], At[m][k], acc[ai][bj][m][n], 0, 0, 0); __builtin_amdgcn_s_setprio(0); } while (0)
#define PG8_WAIT_V(n) asm volatile("s_waitcnt vmcnt(" #n ")" ::: "memory")
#define PG8_WAIT_L(n) asm volatile("s_waitcnt lgkmcnt(" #n ")" ::: "memory")
#define PG8_BAR __builtin_amdgcn_s_barrier()
#define PG8_SCHED __builtin_amdgcn_sched_barrier(0)
    Unit cur, nxt; int ui = 0;
    if (!S.next(0, cur)) return;
    f32x4 acc[2][2][4][2];
#pragma unroll
    for (int a = 0; a < 2; ++a)
#pragma unroll
        for (int b = 0; b < 2; ++b)
#pragma unroll
            for (int m = 0; m < 4; ++m)
#pragma unroll
                for (int n = 0; n < 2; ++n) acc[a][b][m][n] = (f32x4){0.f, 0.f, 0.f, 0.f};
    bf16x8 At[4][2], B0[2][2], B1[2][2];
    const char* cA = (const char*)g.A + (size_t)cur.pm * tstep; const char* cB = (const char*)g.Bt + (size_t)cur.pn * tstep;
    S.a_ready(cur);
    if constexpr (SP2) {
        PG8_STAGE(PG8_SB(0, 0), cB, voffB); PG8_STAGE(PG8_SB(0, 1), cB + hstep, voffB); PG8_STAGE(PG8_SA(0, 0), cA, voffA); PG8_STAGE(PG8_SA(0, 1), cA + hstep, voffA);
        if (wr == 1) PG8_BAR;
        PG8_WAIT_V(2); PG8_BAR;
        PG8_STAGE(PG8_SB(1, 0), cB + kstep, voffB); PG8_STAGE(PG8_SA(1, 0), cA + kstep, voffA); PG8_STAGE(PG8_SB(1, 1), cB + hstep + kstep, voffB);
        PG8_WAIT_V(6); PG8_BAR;
    } else {
        PG8_STAGE(PG8_SB(0, 0), cB, voffB); PG8_STAGE(PG8_SA(0, 0), cA, voffA); PG8_STAGE(PG8_SB(0, 1), cB + hstep, voffB); PG8_STAGE(PG8_SA(0, 1), cA + hstep, voffA);
        if (wr == 1) PG8_BAR;
        PG8_WAIT_V(4); PG8_BAR;
        PG8_STAGE(PG8_SB(1, 0), cB + kstep, voffB); PG8_STAGE(PG8_SA(1, 0), cA + kstep, voffA); PG8_STAGE(PG8_SB(1, 1), cB + hstep + kstep, voffB);
        PG8_WAIT_V(6); PG8_BAR;
    }
    for (;;) {
        const bool has_next = S.next(ui + 1, nxt);
        const char* nA = has_next ? (const char*)g.A + (size_t)nxt.pm * tstep : cA; const char* nB = has_next ? (const char*)g.Bt + (size_t)nxt.pn * tstep : cB;
        for (int t = 0; t < nt; t += 2) {
            const bool last = (t == nt - 2);
            const char* a1 = cA + (size_t)(t + 1) * kstep;
            const char* a2 = last ? nA : cA + (size_t)(t + 2) * kstep; const char* b2 = last ? nB : cB + (size_t)(t + 2) * kstep;
            const char* a3 = a2 + kstep; const char* b3 = b2 + kstep;
            if (last && has_next) S.a_ready(nxt);
            if constexpr (SP2) {
            PG8_LDB(B0, 0, 0); PG8_LDB(B1, 0, 1); PG8_SCHED; PG8_LDA(At, 0, 0); PG8_STAGE(PG8_SA(1, 1), a1 + hstep, voffA);
            PG8_WAIT_V(8); PG8_WAIT_L(0); PG8_BAR; PG8_MMA(0, 0, At, B0); PG8_MMA(0, 1, At, B1); PG8_BAR; PG8_SCHED;
            PG8_LDA(At, 0, 1); PG8_STAGE(PG8_SB(0, 0), b2, voffB); PG8_STAGE(PG8_SB(0, 1), b2 + hstep, voffB); PG8_STAGE(PG8_SA(0, 0), a2, voffA);
            PG8_WAIT_V(8); PG8_WAIT_L(0); PG8_BAR; PG8_MMA(1, 0, At, B0); PG8_MMA(1, 1, At, B1); PG8_BAR; PG8_SCHED;
            PG8_LDB(B0, 1, 0); PG8_LDB(B1, 1, 1); PG8_SCHED; PG8_LDA(At, 1, 0); PG8_STAGE(PG8_SA(0, 1), a2 + hstep, voffA);
            PG8_WAIT_V(8); PG8_WAIT_L(0); PG8_BAR; PG8_MMA(0, 0, At, B0); PG8_MMA(0, 1, At, B1); PG8_BAR; PG8_SCHED;
            PG8_LDA(At, 1, 1); PG8_STAGE(PG8_SB(1, 0), b3, voffB); PG8_STAGE(PG8_SB(1, 1), b3 + hstep, voffB); PG8_STAGE(PG8_SA(1, 0), a3, voffA);
            PG8_WAIT_V(8); PG8_WAIT_L(0); PG8_BAR; PG8_MMA(1, 0, At, B0); PG8_MMA(1, 1, At, B1); PG8_BAR; PG8_SCHED;
            } else {
            PG8_LDB(B0, 0, 0); PG8_SCHED; PG8_LDA(At, 0, 0); PG8_STAGE(PG8_SA(1, 1), a1 + hstep, voffA);
            PG8_WAIT_L(8); PG8_BAR; PG8_WAIT_L(0); PG8_MMA(0, 0, At, B0); PG8_BAR; PG8_SCHED;
            PG8_LDB(B1, 0, 1); PG8_STAGE(PG8_SB(0, 0), b2, voffB);
            PG8_BAR; PG8_WAIT_L(0); PG8_MMA(0, 1, At, B1); PG8_BAR;
            PG8_LDA(At, 0, 1); PG8_STAGE(PG8_SA(0, 0), a2, voffA);
            PG8_BAR; PG8_WAIT_L(0); PG8_MMA(1, 0, At, B0); PG8_BAR; PG8_SCHED;
            PG8_STAGE(PG8_SB(0, 1), b2 + hstep, voffB);
            PG8_WAIT_V(6); PG8_BAR; PG8_MMA(1, 1, At, B1); PG8_BAR;
            PG8_LDB(B0, 1, 0); PG8_SCHED; PG8_LDA(At, 1, 0); PG8_STAGE(PG8_SA(0, 1), a2 + hstep, voffA);
            PG8_WAIT_L(8); PG8_BAR; PG8_WAIT_L(0); PG8_MMA(0, 0, At, B0); PG8_BAR; PG8_SCHED;
            PG8_LDB(B1, 1, 1); PG8_STAGE(PG8_SB(1, 0), b3, voffB);
            PG8_BAR; PG8_WAIT_L(0); PG8_MMA(0, 1, At, B1); PG8_BAR;
            PG8_LDA(At, 1, 1); PG8_STAGE(PG8_SA(1, 0), a3, voffA);
            PG8_BAR; PG8_WAIT_L(0); PG8_MMA(1, 0, At, B0); PG8_BAR; PG8_SCHED;
            PG8_STAGE(PG8_SB(1, 1), b3 + hstep, voffB);
            PG8_WAIT_V(6); PG8_BAR; PG8_MMA(1, 1, At, B1); PG8_BAR;
            }
        }
        if constexpr (ALIGN_EPI) { if (wr == 0) PG8_BAR; }
        if constexpr (!Epi::AFTER_DRAIN) { E(acc, cur, wr, wc, fr, fq); S.done(cur); }
        if (!has_next) break;
#pragma unroll
        for (int a = 0; a < 2; ++a)
#pragma unroll
            for (int b = 0; b < 2; ++b)
#pragma unroll
                for (int m = 0; m < 4; ++m)
#pragma unroll
                    for (int n = 0; n < 2; ++n) acc[a][b][m][n] = (f32x4){0.f, 0.f, 0.f, 0.f};
        cur = nxt; cA = nA; cB = nB; ++ui;
        if constexpr (ALIGN_EPI) { if (wr == 1) PG8_BAR; }
    }
    PG8_WAIT_V(0);
    if constexpr (!ALIGN_EPI) { if (wr == 0) PG8_BAR; }
    PG8_BAR;
    if constexpr (Epi::AFTER_DRAIN) { E.fused(acc, cur, wr, wc, fr, fq, lds, wid, lane); S.done(cur); }
#undef PG8_SA
#undef PG8_SB
#undef PG8_STAGE
#undef PG8_LDA
#undef PG8_LDB
#undef PG8_MMA
#undef PG8_WAIT_V
#undef PG8_WAIT_L
#undef PG8_BAR
#undef PG8_SCHED
}
}
#ifndef PG8_SP2
#define PG8_SP2 true
#endif
#ifndef PG8_ALIGN
#define PG8_ALIGN true
#endif

constexpr int NB = 8, SEQ = 4096, DM = 1024, MTOK = NB * SEQ;
constexpr int SWA_QKV = 1280, DIFF_QKV = 3072, DFF = 2816, DUP = 2 * DFF;
constexpr float EPS = 1e-6f;
constexpr float LOG2E = 1.4426950408889634f;
constexpr float C2 = 0.125f * LOG2E;
constexpr float LAMBDA_INIT1 = 0.35550906759096926f;

#define LAS __attribute__((address_space(3)))
typedef unsigned short bf16;
typedef float f32x4 __attribute__((ext_vector_type(4)));
typedef float f32x16 __attribute__((ext_vector_type(16)));
typedef short bf16x8 __attribute__((ext_vector_type(8)));
typedef short s16x4 __attribute__((ext_vector_type(4)));
typedef unsigned u32x4 __attribute__((ext_vector_type(4)));
typedef unsigned u32x2 __attribute__((ext_vector_type(2)));

constexpr int NWAVES = 8, NTHREADS = 512;
constexpr int LDS_BYTES = 135168;

constexpr size_t MiB = 1u << 20;
constexpr size_t WS_WQKV0 = 0;
constexpr size_t WS_WO0   = 3 * MiB;
constexpr size_t WS_WQKV1 = 5 * MiB;
constexpr size_t WS_WO1   = 11 * MiB;
constexpr size_t WS_WUP0  = 13 * MiB;
constexpr size_t WS_WUP1  = 24 * MiB;
constexpr size_t WS_WDN0  = 35 * MiB;
constexpr size_t WS_WDN1  = 41 * MiB;
constexpr size_t WS_H     = 48 * MiB;
constexpr size_t WS_QKV   = 112 * MiB;
constexpr size_t WS_AO    = 304 * MiB;
constexpr size_t WS_MO    = 368 * MiB;
constexpr size_t WS_UG    = 112 * MiB;
constexpr size_t WS_UV    = 288 * MiB;
constexpr size_t WS_HALO  = 464 * MiB;
constexpr size_t WS_END   = 488 * MiB;

__device__ __forceinline__ unsigned f2bf(float f) { unsigned u = __builtin_bit_cast(unsigned, f); return (u + 0x7fffu + ((u >> 16) & 1u)) >> 16; }
__device__ __forceinline__ unsigned pk2(float lo, float hi) { return f2bf(lo) | (f2bf(hi) << 16); }
__device__ __forceinline__ float bf2f(unsigned short b) { return __builtin_bit_cast(float, (unsigned)b << 16); }
__device__ __forceinline__ float bflo(unsigned w) { return __builtin_bit_cast(float, w << 16); }
__device__ __forceinline__ float bfhi(unsigned w) { return __builtin_bit_cast(float, w & 0xffff0000u); }
__device__ __forceinline__ float wave_sum(float v) {
#pragma unroll
    for (int o = 1; o < 64; o <<= 1) v += __shfl_xor(v, o);
    return v;
}

struct Args {
    const float* x; const float* mix_pre_g; const float* mix_post_g; const float* ffn_pre_g; const float* ffn_post_g;
    const float* swa_w_qkv; const float* swa_sinks; const float* swa_w_o;
    const float* diff_w_qkv; const float* lq1; const float* lk1; const float* lq2; const float* lk2; const float* subln_g; const float* diff_w_o;
    const float* w_up; const float* conv_w; const float* conv_b; const float* w_down;
    float* out; unsigned char* ws; int ph_lo, ph_hi;
};

__device__ __forceinline__ void transpose_item(const float* W, int K, int N, bf16* WT, LAS float* scr, int item, int lane) {
    const int nblk = N / 32, kb = item / nblk, nb = item % nblk, k0 = 64 * kb, n0 = 32 * nb;
#pragma unroll 8
    for (int i = 0; i < 32; ++i) { const int kk = 2 * i + (lane >> 5); scr[kk * 33 + (lane & 31)] = W[(size_t)(k0 + kk) * N + n0 + (lane & 31)]; }
    asm volatile("s_waitcnt lgkmcnt(0)" ::: "memory");
    const int c = lane & 7;
#pragma unroll
    for (int j = 0; j < 4; ++j) { const int n = (lane >> 3) + 8 * j; const LAS float* s = scr + (8 * c) * 33 + n;
        u32x4 o; o.x = pk2(s[0 * 33], s[1 * 33]); o.y = pk2(s[2 * 33], s[3 * 33]); o.z = pk2(s[4 * 33], s[5 * 33]); o.w = pk2(s[6 * 33], s[7 * 33]);
        *(u32x4*)(WT + (size_t)(n0 + n) * K + k0 + 8 * c) = o; }
    asm volatile("s_waitcnt lgkmcnt(0)" ::: "memory");
}

template <int MODE>
__device__ __forceinline__ void norm_rows(const float* xin, const bf16* mrow, const float* gpost, const float* gnext, float* xout, bf16* hout, int gw, int ngw, int lane) {
    for (int row = gw; row < MTOK; row += ngw) {
        const f32x4* xr = (const f32x4*)(xin + (size_t)row * DM) + lane;
        f32x4 v[4];
#pragma unroll
        for (int j = 0; j < 4; ++j) v[j] = xr[64 * j];
        if (MODE == 1) {
            const u32x2* mr = (const u32x2*)(mrow + (size_t)row * DM) + lane;
            f32x4 mv[4]; float s = 0.f;
#pragma unroll
            for (int j = 0; j < 4; ++j) { const u32x2 w = mr[64 * j]; mv[j] = (f32x4){bflo(w.x), bfhi(w.x), bflo(w.y), bfhi(w.y)};
                s += (mv[j].x * mv[j].x + mv[j].y * mv[j].y) + (mv[j].z * mv[j].z + mv[j].w * mv[j].w); }
            const float rs = 1.0f / sqrtf(wave_sum(s) * (1.f / DM) + EPS);
            f32x4* xo = (f32x4*)(xout + (size_t)row * DM) + lane;
#pragma unroll
            for (int j = 0; j < 4; ++j) { const f32x4 g = ((const f32x4*)gpost)[lane + 64 * j]; v[j] = v[j] + mv[j] * rs * g; xo[64 * j] = v[j]; }
        }
        if (MODE == 0 || gnext != nullptr) {
            const float* gg = (MODE == 0) ? gpost : gnext;
            float s = 0.f;
#pragma unroll
            for (int j = 0; j < 4; ++j) s += (v[j].x * v[j].x + v[j].y * v[j].y) + (v[j].z * v[j].z + v[j].w * v[j].w);
            const float rs = 1.0f / sqrtf(wave_sum(s) * (1.f / DM) + EPS);
            u32x2* ho = (u32x2*)(hout + (size_t)row * DM) + lane;
#pragma unroll
            for (int j = 0; j < 4; ++j) { const f32x4 g = ((const f32x4*)gg)[lane + 64 * j]; const f32x4 y = v[j] * rs * g; u32x2 w; w.x = pk2(y.x, y.y); w.y = pk2(y.z, y.w); ho[64 * j] = w; }
        }
    }
}

__device__ __forceinline__ float gelu_tanh(float g) {
    const float z = 0.7978845608028654f * (g + 0.044715f * g * g * g);
    const float e = __builtin_amdgcn_exp2f(-2.0f * LOG2E * z);
    return g * __builtin_amdgcn_rcpf(1.0f + e);
}
__device__ __forceinline__ void unpack8(const u32x4 w, float* f) { f[0] = bflo(w.x); f[1] = bfhi(w.x); f[2] = bflo(w.y); f[3] = bfhi(w.y); f[4] = bflo(w.z); f[5] = bfhi(w.z); f[6] = bflo(w.w); f[7] = bfhi(w.w); }
constexpr int CONV_RUN = 16;
__device__ __forceinline__ void conv_gelu_phase(bf16* UG, const bf16* UV, const bf16* HALO, const float* cw, const float* cb, int gtid, int ngt) {
    constexpr int NCH = DFF / 8;
    constexpr int NTASK = NCH * (MTOK / CONV_RUN);
    for (int task = gtid; task < NTASK; task += ngt) {
        const int ch = task % NCH, run = task / NCH, t0 = run * CONV_RUN, c0 = ch * 8;
        float wg[3][8], wv[3][8], bg[8], bv[8];
#pragma unroll
        for (int tap = 0; tap < 3; ++tap) {
            const f32x4 a = *(const f32x4*)(cw + tap * DUP + c0), b = *(const f32x4*)(cw + tap * DUP + c0 + 4);
            const f32x4 c = *(const f32x4*)(cw + tap * DUP + DFF + c0), d = *(const f32x4*)(cw + tap * DUP + DFF + c0 + 4);
#pragma unroll
            for (int k = 0; k < 4; ++k) { wg[tap][k] = a[k]; wg[tap][4 + k] = b[k]; wv[tap][k] = c[k]; wv[tap][4 + k] = d[k]; }
        }
        { const f32x4 a = *(const f32x4*)(cb + c0), b = *(const f32x4*)(cb + c0 + 4), c = *(const f32x4*)(cb + DFF + c0), d = *(const f32x4*)(cb + DFF + c0 + 4);
#pragma unroll
          for (int k = 0; k < 4; ++k) { bg[k] = a[k]; bg[4 + k] = b[k]; bv[k] = c[k]; bv[4 + k] = d[k]; } }
        float g2[8], g1[8], v2[8], v1[8];
        const bool seq_start = (t0 % SEQ) == 0;
        if (seq_start) {
#pragma unroll
            for (int k = 0; k < 8; ++k) { g2[k] = 0.f; g1[k] = 0.f; v2[k] = 0.f; v1[k] = 0.f; }
        } else {
            unpack8(*(const u32x4*)(HALO + (size_t)((run - 1) * 2 + 0) * DFF + c0), g2); unpack8(*(const u32x4*)(HALO + (size_t)((run - 1) * 2 + 1) * DFF + c0), g1);
            unpack8(*(const u32x4*)(UV + (size_t)(t0 - 2) * DFF + c0), v2); unpack8(*(const u32x4*)(UV + (size_t)(t0 - 1) * DFF + c0), v1);
        }
#pragma unroll 4
        for (int t = 0; t < CONV_RUN; ++t) {
            float g0[8], v0[8];
            unpack8(*(const u32x4*)(UG + (size_t)(t0 + t) * DFF + c0), g0); unpack8(*(const u32x4*)(UV + (size_t)(t0 + t) * DFF + c0), v0);
            float r[8];
#pragma unroll
            for (int k = 0; k < 8; ++k) {
                const float cgv = bg[k] + wg[0][k] * g2[k] + wg[1][k] * g1[k] + wg[2][k] * g0[k];
                const float cvv = bv[k] + wv[0][k] * v2[k] + wv[1][k] * v1[k] + wv[2][k] * v0[k];
                r[k] = gelu_tanh(cgv) * cvv;
                g2[k] = g1[k]; g1[k] = g0[k]; v2[k] = v1[k]; v1[k] = v0[k];
            }
            u32x4 o; o.x = pk2(r[0], r[1]); o.y = pk2(r[2], r[3]); o.z = pk2(r[4], r[5]); o.w = pk2(r[6], r[7]);
            *(u32x4*)(UG + (size_t)(t0 + t) * DFF + c0) = o;
        }
    }
}

struct EpiUp {
    static constexpr bool PERM = true, AFTER_DRAIN = false;
    bf16* UG; bf16* UV; bf16* HALO;
    __device__ __forceinline__ void operator()(const pg8::f32x4 (&acc)[2][2][4][2], const pg8::Unit& u, int wr, int wc, int fr, int fq) const {
        const int row0 = u.pm * 256 + wr * 64 + fr; int colt = u.pn * 256; bf16* base = UG; bool gate = true;
        if (colt >= DFF) { colt -= DFF; base = UV; gate = false; }
        const int col0 = colt + wc * 32 + 8 * fq;
#pragma unroll
        for (int ai = 0; ai < 2; ++ai)
#pragma unroll
            for (int m = 0; m < 4; ++m) { const int row = row0 + ai * 128 + m * 16; bf16* rowp = base + (size_t)row * DFF + col0;
#pragma unroll
                for (int bj = 0; bj < 2; ++bj) { const pg8::f32x4 v0 = acc[ai][bj][m][0], v1 = acc[ai][bj][m][1];
                    u32x4 w; w.x = pg8::cvt_pk_bf16(v0[0], v0[1]); w.y = pg8::cvt_pk_bf16(v0[2], v0[3]); w.z = pg8::cvt_pk_bf16(v1[0], v1[1]); w.w = pg8::cvt_pk_bf16(v1[2], v1[3]);
                    *(u32x4*)(rowp + bj * 128) = w;
                    if (gate && fr >= 14) *(u32x4*)(HALO + (size_t)((row >> 4) * 2 + (fr - 14)) * DFF + col0 + bj * 128) = w; } }
    }
};

typedef short v4i16_t __attribute__((ext_vector_type(4)));
__device__ __forceinline__ int pi32(int r) { return (r & ~12) | ((r & 4) << 1) | ((r & 8) >> 1); }
__device__ __forceinline__ s16x4 tr_read(LAS const unsigned char* p) { return __builtin_bit_cast(s16x4, __builtin_amdgcn_ds_read_tr16_b64_v4i16((LAS v4i16_t*)p)); }

template <int NDB, int VP>
__device__ __forceinline__ void attn_block(f32x16 (&o)[NDB], float& m, float& l, const bf16x8 (&qf)[4], LAS const unsigned char* kp, LAS const unsigned char* vp,
                                           int rel0, float slope2, bool mask, int window) {
    f32x16 s = {};
#pragma unroll
    for (int ks = 0; ks < 4; ++ks) { const bf16x8 kf = *(LAS const bf16x8*)(kp + ks * 32); s = __builtin_amdgcn_mfma_f32_32x32x16_bf16(kf, qf[ks], s, 0, 0, 0); }
    const float base = slope2 * (float)rel0;
#pragma unroll
    for (int i = 0; i < 16; ++i) { const int off = (i & 7) + 16 * (i >> 3); s[i] = fmaf(s[i], C2, fmaf(slope2, (float)off, base)); }
    if (mask) {
#pragma unroll
        for (int i = 0; i < 16; ++i) { const int rel = rel0 + (i & 7) + 16 * (i >> 3); if (rel > 0 || rel <= -window) s[i] = -INFINITY; }
    }
    float mx = fmaxf(fmaxf(s[0], s[1]), fmaxf(s[2], s[3]));
#pragma unroll
    for (int i = 4; i < 16; i += 4) mx = fmaxf(mx, fmaxf(fmaxf(s[i], s[i + 1]), fmaxf(s[i + 2], s[i + 3])));
    mx = fmaxf(mx, __shfl_xor(mx, 32));
    const float mn = fmaxf(m, mx);
    const float alpha = __builtin_amdgcn_exp2f(m - mn);
    m = mn;
    float ls = 0.f;
#pragma unroll
    for (int i = 0; i < 16; ++i) { s[i] = __builtin_amdgcn_exp2f(s[i] - mn); ls += s[i]; }
    l = l * alpha + ls;
    if (!__all(alpha == 1.0f)) {
#pragma unroll
        for (int db = 0; db < NDB; ++db)
#pragma unroll
            for (int i = 0; i < 16; ++i) o[db][i] *= alpha;
    }
    bf16x8 pf[2];
#pragma unroll
    for (int ss = 0; ss < 2; ++ss) { u32x4 w; w.x = pg8::cvt_pk_bf16(s[8 * ss + 0], s[8 * ss + 1]); w.y = pg8::cvt_pk_bf16(s[8 * ss + 2], s[8 * ss + 3]);
        w.z = pg8::cvt_pk_bf16(s[8 * ss + 4], s[8 * ss + 5]); w.w = pg8::cvt_pk_bf16(s[8 * ss + 6], s[8 * ss + 7]); pf[ss] = __builtin_bit_cast(bf16x8, w); }
#pragma unroll
    for (int ss = 0; ss < 2; ++ss)
#pragma unroll
        for (int db = 0; db < NDB; ++db) {
            LAS const unsigned char* a = vp + (16 * ss) * VP + db * 64;
            const s16x4 lo = tr_read(a), hi4 = tr_read(a + 4 * VP);
            const bf16x8 vf = (bf16x8){lo[0], lo[1], lo[2], lo[3], hi4[0], hi4[1], hi4[2], hi4[3]};
            o[db] = __builtin_amdgcn_mfma_f32_32x32x16_bf16(vf, pf[ss], o[db], 0, 0, 0);
        }
}

__device__ __forceinline__ void swa_attn_phase(LAS unsigned char* lds, const bf16* QKV, bf16* AO, const float* sinks, int tid, int lane, int wave) {
    constexpr int KP = 144, VP = 192, KBYTES = 256 * KP;
    const int r32 = lane & 31, hi = lane >> 5;
    LAS const unsigned char* kbase = lds + pi32(r32) * KP + hi * 16;
    LAS const unsigned char* vbase = lds + KBYTES + (8 * hi + ((lane & 15) >> 2)) * VP + (16 * ((lane >> 4) & 1) + 4 * (lane & 3)) * 2;
    for (int u = blockIdx.x; u < NB * 2 * 32; u += gridDim.x) {
        const int b = u >> 6, kvh = (u >> 5) & 1, n = u & 31, hq = kvh * 8 + wave;
        const int j0 = (n == 0) ? 128 : 0;
        const size_t rowbase = (size_t)b * SEQ;
#pragma unroll
        for (int i = 0; i < 4; ++i) {
            const int cidx = tid + 512 * i, row = cidx >> 3, ch = cidx & 7;
            if (row >= j0) {
                const bf16* g = QKV + (rowbase + (size_t)(n * 128 - 128 + row)) * SWA_QKV + 1024 + kvh * 64 + ch * 8;
                const u32x4 kv = *(const u32x4*)g, vv = *(const u32x4*)(g + 128);
                *(LAS u32x4*)(lds + row * KP + ch * 16) = kv; *(LAS u32x4*)(lds + KBYTES + row * VP + ch * 16) = vv;
            }
        }
        __syncthreads();
        const float slope2 = exp2f(-0.5f * (float)(hq + 1)) * LOG2E;
        const float sink2 = sinks[hq] * LOG2E;
        for (int qb = 0; qb < 4; ++qb) {
            const int Q0 = n * 128 + 32 * qb;
            const bf16* qptr = QKV + (rowbase + (size_t)(Q0 + r32)) * SWA_QKV + hq * 64 + hi * 8;
            bf16x8 qf[4];
#pragma unroll
            for (int ks = 0; ks < 4; ++ks) qf[ks] = *(const bf16x8*)(qptr + ks * 16);
            f32x16 o[2]; o[0] = f32x16{}; o[1] = f32x16{};
            float m = -1e30f, l = 0.f;
            for (int k = 0; k < 5; ++k) {
                const int kb_abs = Q0 - 32 * k; if (kb_abs < 0) break;
                const int trow = 128 + 32 * qb - 32 * k;
                attn_block<2, VP>(o, m, l, qf, kbase + trow * KP, vbase + trow * VP, kb_abs + 8 * hi - (Q0 + r32), slope2, (k == 0 || k == 4), 128);
            }
            const float lt = l + __shfl_xor(l, 32) + __builtin_amdgcn_exp2f(sink2 - m);
            const float inv = 1.0f / lt;
            bf16* op = AO + (rowbase + (size_t)(Q0 + r32)) * DM + hq * 64 + 4 * hi;
#pragma unroll
            for (int db = 0; db < 2; ++db)
#pragma unroll
                for (int a = 0; a < 4; ++a) { u32x2 w; w.x = pk2(o[db][4 * a] * inv, o[db][4 * a + 1] * inv); w.y = pk2(o[db][4 * a + 2] * inv, o[db][4 * a + 3] * inv);
                    *(u32x2*)(op + 32 * db + 8 * a) = w; }
        }
        __syncthreads();
    }
}

__device__ __forceinline__ void diff_attn_phase(LAS unsigned char* lds, const bf16* QKV, bf16* AO, const float* lq1, const float* lk1, const float* lq2, const float* lk2, const float* subg,
                                                int tid, int lane, int wave) {
    constexpr int KP = 272, VP = 320, KBYTES = 64 * KP, STAGE = KBYTES + 64 * VP;
    const int r32 = lane & 31, hi = lane >> 5, rg = wave & 3, c = wave >> 2;
    const float lam = expf(wave_sum(lq1[lane] * lk1[lane])) - expf(wave_sum(lq2[lane] * lk2[lane])) + LAMBDA_INIT1;
    const int koff = pi32(r32) * KP + c * 128 + hi * 16;
    const int voff = KBYTES + (8 * hi + ((lane & 15) >> 2)) * VP + (16 * ((lane >> 4) & 1) + 4 * (lane & 3)) * 2;
    const int srow0 = tid >> 4, sch = tid & 15;
    for (int p = blockIdx.x; p < 1024; p += gridDim.x) {
        const int bh = p >> 4, sidx = p & 15, b = bh >> 3, h = bh & 7;
        const size_t rowbase = (size_t)b * SEQ;
        const float slope2 = exp2f(-(float)(h + 1)) * LOG2E;
        for (int which = 0; which < 2; ++which) {
            const int qblk = which ? 31 - sidx : sidx;
            const int qrow0 = qblk * 128 + rg * 32;
            const bf16* qptr = QKV + (rowbase + (size_t)(qrow0 + r32)) * DIFF_QKV + (h * 2 + c) * 64 + hi * 8;
            bf16x8 qf[4];
#pragma unroll
            for (int ks = 0; ks < 4; ++ks) qf[ks] = *(const bf16x8*)(qptr + ks * 16);
            f32x16 o[4];
#pragma unroll
            for (int db = 0; db < 4; ++db) o[db] = f32x16{};
            float m = -1e30f, l = 0.f;
            const int ntiles = 2 * qblk + 2;
            const bf16* gk = QKV + (rowbase + (size_t)srow0) * DIFF_QKV + 1024 + h * 128 + sch * 8;
            u32x4 kr[2], vr[2];
            {   const bf16* g = gk + (size_t)((ntiles - 1) * 64) * DIFF_QKV;
#pragma unroll
                for (int i = 0; i < 2; ++i) { kr[i] = *(const u32x4*)(g + (size_t)(32 * i) * DIFF_QKV); vr[i] = *(const u32x4*)(g + (size_t)(32 * i) * DIFF_QKV + 1024); } }
            for (int t = ntiles - 1; t >= 0; --t) {
                LAS unsigned char* st = lds + (t & 1) * STAGE;
#pragma unroll
                for (int i = 0; i < 2; ++i) { *(LAS u32x4*)(st + (srow0 + 32 * i) * KP + sch * 16) = kr[i]; *(LAS u32x4*)(st + KBYTES + (srow0 + 32 * i) * VP + sch * 16) = vr[i]; }
                __syncthreads();
                if (t > 0) { const bf16* g = gk + (size_t)((t - 1) * 64) * DIFF_QKV;
#pragma unroll
                    for (int i = 0; i < 2; ++i) { kr[i] = *(const u32x4*)(g + (size_t)(32 * i) * DIFF_QKV); vr[i] = *(const u32x4*)(g + (size_t)(32 * i) * DIFF_QKV + 1024); } }
#pragma unroll
                for (int blk = 1; blk >= 0; --blk) {
                    const int kb_abs = t * 64 + blk * 32;
                    if (kb_abs > qrow0 + 31) continue;
                    attn_block<4, VP>(o, m, l, qf, st + koff + blk * 32 * KP, st + voff + blk * 32 * VP, kb_abs + 8 * hi - (qrow0 + r32), slope2, kb_abs + 31 > qrow0, 1 << 30);
                }
            }
            const float inv = 1.0f / (l + __shfl_xor(l, 32));
            __syncthreads();
            LAS float* xch = (LAS float*)lds;
            if (c == 1) {
#pragma unroll
                for (int db = 0; db < 4; ++db)
#pragma unroll
                    for (int i = 0; i < 16; ++i) { const int d = 32 * db + (i & 3) + 8 * (i >> 2) + 4 * hi; xch[(rg * 128 + d) * 32 + r32] = o[db][i] * inv; }
            }
            __syncthreads();
            if (c == 0) {
                float ssq = 0.f;
#pragma unroll
                for (int db = 0; db < 4; ++db)
#pragma unroll
                    for (int i = 0; i < 16; ++i) { const int d = 32 * db + (i & 3) + 8 * (i >> 2) + 4 * hi; const float v = o[db][i] * inv - lam * xch[(rg * 128 + d) * 32 + r32]; o[db][i] = v; ssq += v * v; }
                ssq += __shfl_xor(ssq, 32);
                const float rs = (1.0f - LAMBDA_INIT1) / sqrtf(ssq * (1.0f / 128.0f) + EPS);
                bf16* op = AO + (rowbase + (size_t)(qrow0 + r32)) * DM + h * 128 + 4 * hi;
#pragma unroll
                for (int db = 0; db < 4; ++db)
#pragma unroll
                    for (int a = 0; a < 4; ++a) { const f32x4 g = *(const f32x4*)(subg + 32 * db + 8 * a + 4 * hi);
                        u32x2 w; w.x = pk2(o[db][4 * a] * rs * g.x, o[db][4 * a + 1] * rs * g.y); w.y = pk2(o[db][4 * a + 2] * rs * g.z, o[db][4 * a + 3] * rs * g.w);
                        *(u32x2*)(op + 32 * db + 8 * a) = w; }
            }
            __syncthreads();
        }
    }
}

__global__ void __launch_bounds__(NTHREADS, 2) hybrid_fwd(Args a) {
    extern __shared__ __attribute__((aligned(16))) unsigned char lds_raw[];
    LAS unsigned char* lds = (LAS unsigned char*)lds_raw;
    const int tid = threadIdx.x, lane = tid & 63, wave = __builtin_amdgcn_readfirstlane(tid >> 6);
    const int G = gridDim.x, gw = blockIdx.x * NWAVES + wave, ngw = G * NWAVES;
    unsigned char* ws = a.ws;
    bf16* Wqkv0 = (bf16*)(ws + WS_WQKV0); bf16* Wo0 = (bf16*)(ws + WS_WO0); bf16* Wqkv1 = (bf16*)(ws + WS_WQKV1); bf16* Wo1 = (bf16*)(ws + WS_WO1);
    bf16* Wup[2] = {(bf16*)(ws + WS_WUP0), (bf16*)(ws + WS_WUP1)}; bf16* Wdn[2] = {(bf16*)(ws + WS_WDN0), (bf16*)(ws + WS_WDN1)};
    bf16* H = (bf16*)(ws + WS_H); bf16* QKV = (bf16*)(ws + WS_QKV); bf16* AO = (bf16*)(ws + WS_AO); bf16* MO = (bf16*)(ws + WS_MO);
    bf16* UG = (bf16*)(ws + WS_UG); bf16* UV = (bf16*)(ws + WS_UV); bf16* HALO = (bf16*)(ws + WS_HALO);
    const int lo = a.ph_lo, hi = a.ph_hi;
#define IN(k) (lo <= (k) && (k) < hi)
#define SEAM(k) do { if (IN(k) && IN((k) + 1)) cg::this_grid().sync(); } while (0)
#define GEMM_BF16(Aptr, Btptr, Nn, Kk, Optr) do { pg8::Gemm g{(const pg8::bf16_t*)(Aptr), (const pg8::bf16_t*)(Btptr), MTOK, (Nn), (Kk)}; pg8::StaticOrder S; S.init(MTOK, (Nn), G, (int)blockIdx.x); \
        pg8::EpiBf16<0> E{(pg8::bf16_t*)(Optr), (Nn), nullptr, 0, 0, 1.f}; pg8::gemm_phase<pg8::EpiBf16<0>, pg8::StaticOrder, PG8_ALIGN, PG8_SP2>(lds, g, S, E); } while (0)

    if (IN(0)) {
        LAS float* scr = (LAS float*)(lds + wave * 16384);
        constexpr int I0 = (DM / 64) * (SWA_QKV / 32), I1 = (DM / 64) * (DM / 32), I2 = (DM / 64) * (DIFF_QKV / 32), I3 = I1, I4 = (DM / 64) * (DUP / 32), I5 = I4, I6 = (DFF / 64) * (DM / 32), I7 = I6;
        constexpr int NIT = I0 + I1 + I2 + I3 + I4 + I5 + I6 + I7;
        for (int it = gw; it < NIT; it += ngw) {
            int r = it;
            if (r < I0) { transpose_item(a.swa_w_qkv, DM, SWA_QKV, Wqkv0, scr, r, lane); continue; } r -= I0;
            if (r < I1) { transpose_item(a.swa_w_o, DM, DM, Wo0, scr, r, lane); continue; } r -= I1;
            if (r < I2) { transpose_item(a.diff_w_qkv, DM, DIFF_QKV, Wqkv1, scr, r, lane); continue; } r -= I2;
            if (r < I3) { transpose_item(a.diff_w_o, DM, DM, Wo1, scr, r, lane); continue; } r -= I3;
            if (r < I4) { transpose_item(a.w_up, DM, DUP, Wup[0], scr, r, lane); continue; } r -= I4;
            if (r < I5) { transpose_item(a.w_up + (size_t)DM * DUP, DM, DUP, Wup[1], scr, r, lane); continue; } r -= I5;
            if (r < I6) { transpose_item(a.w_down, DFF, DM, Wdn[0], scr, r, lane); continue; } r -= I6;
            transpose_item(a.w_down + (size_t)DFF * DM, DFF, DM, Wdn[1], scr, r, lane);
        }
        norm_rows<0>(a.x, nullptr, a.mix_pre_g, nullptr, nullptr, H, gw, ngw, lane);
    }
    SEAM(0);
    if (IN(1)) GEMM_BF16(H, Wqkv0, SWA_QKV, DM, QKV);
    SEAM(1);
    if (IN(2)) swa_attn_phase(lds, QKV, AO, a.swa_sinks, tid, lane, wave);
    SEAM(2);
    if (IN(3)) GEMM_BF16(AO, Wo0, DM, DM, MO);
    SEAM(3);
    if (IN(4)) norm_rows<1>(a.x, MO, a.mix_post_g, a.ffn_pre_g, a.out, H, gw, ngw, lane);
    SEAM(4);
#define FFN_PHASES(P, L) \
    if (IN(P)) { pg8::Gemm g{(const pg8::bf16_t*)H, (const pg8::bf16_t*)Wup[L], MTOK, DUP, DM}; pg8::StaticOrder S; S.init(MTOK, DUP, G, (int)blockIdx.x); EpiUp E{UG, UV, HALO}; \
        pg8::gemm_phase<EpiUp, pg8::StaticOrder, PG8_ALIGN, PG8_SP2>(lds, g, S, E); } \
    SEAM(P); \
    if (IN((P) + 1)) conv_gelu_phase(UG, UV, HALO, a.conv_w + (size_t)(L) * 3 * DUP, a.conv_b + (size_t)(L) * DUP, blockIdx.x * NTHREADS + tid, G * NTHREADS); \
    SEAM((P) + 1); \
    if (IN((P) + 2)) GEMM_BF16(UG, Wdn[L], DM, DFF, MO); \
    SEAM((P) + 2);
    FFN_PHASES(5, 0)
    if (IN(8)) norm_rows<1>(a.out, MO, a.ffn_post_g, a.mix_pre_g + DM, a.out, H, gw, ngw, lane);
    SEAM(8);
    if (IN(9)) GEMM_BF16(H, Wqkv1, DIFF_QKV, DM, QKV);
    SEAM(9);
    if (IN(10)) diff_attn_phase(lds, QKV, AO, a.lq1, a.lk1, a.lq2, a.lk2, a.subln_g, tid, lane, wave);
    SEAM(10);
    if (IN(11)) GEMM_BF16(AO, Wo1, DM, DM, MO);
    SEAM(11);
    if (IN(12)) norm_rows<1>(a.out, MO, a.mix_post_g + DM, a.ffn_pre_g + DM, a.out, H, gw, ngw, lane);
    SEAM(12);
    FFN_PHASES(13, 1)
    if (IN(16)) norm_rows<1>(a.out, MO, a.ffn_post_g + DM, nullptr, a.out, H, gw, ngw, lane);
#undef IN
#undef SEAM
}

#ifndef MK_PER_PHASE
#define MK_PER_PHASE 0
#endif
constexpr int NPHASES = 17;

extern "C" void kernel_launch(void* const* d_in, const int* in_sizes, int n_in, void* d_out, int out_size, void* d_ws, size_t ws_size, hipStream_t stream) {
    static int grid = 0;
    if (grid == 0) {
        if (n_in != 19 || in_sizes[0] != MTOK * DM || out_size != MTOK * DM || ws_size < WS_END) {
            fprintf(stderr, "kernel_launch: unexpected sizes n_in %d in0 %d out %d ws %zu (need %zu)\n", n_in, n_in > 0 ? in_sizes[0] : -1, out_size, ws_size, (size_t)WS_END); grid = -1; return; }
        int dev = 0, cus = 0, per_cu = 0;
        (void)hipGetDevice(&dev); (void)hipDeviceGetAttribute(&cus, hipDeviceAttributeMultiprocessorCount, dev);
        if (hipFuncSetAttribute((const void*)hybrid_fwd, hipFuncAttributeMaxDynamicSharedMemorySize, LDS_BYTES) != hipSuccess) { fprintf(stderr, "kernel_launch: hipFuncSetAttribute failed\n"); grid = -1; return; }
        if (hipOccupancyMaxActiveBlocksPerMultiprocessor(&per_cu, (const void*)hybrid_fwd, NTHREADS, LDS_BYTES) != hipSuccess || per_cu < 1) { fprintf(stderr, "kernel_launch: occupancy query says %d\n", per_cu); per_cu = 1; }
        (void)hipGetLastError();
        grid = cus * 1;
        if (grid <= 0) grid = 256;
    }
    if (grid < 0) return;
    Args a{};
    a.x = (const float*)d_in[0]; a.mix_pre_g = (const float*)d_in[1]; a.mix_post_g = (const float*)d_in[2]; a.ffn_pre_g = (const float*)d_in[3]; a.ffn_post_g = (const float*)d_in[4];
    a.swa_w_qkv = (const float*)d_in[5]; a.swa_sinks = (const float*)d_in[6]; a.swa_w_o = (const float*)d_in[7];
    a.diff_w_qkv = (const float*)d_in[8]; a.lq1 = (const float*)d_in[9]; a.lk1 = (const float*)d_in[10]; a.lq2 = (const float*)d_in[11]; a.lk2 = (const float*)d_in[12];
    a.subln_g = (const float*)d_in[13]; a.diff_w_o = (const float*)d_in[14];
    a.w_up = (const float*)d_in[15]; a.conv_w = (const float*)d_in[16]; a.conv_b = (const float*)d_in[17]; a.w_down = (const float*)d_in[18];
    a.out = (float*)d_out; a.ws = (unsigned char*)d_ws;
#if MK_PER_PHASE
    for (int p = 0; p < NPHASES; ++p) { a.ph_lo = p; a.ph_hi = p + 1; hipLaunchKernelGGL(hybrid_fwd, dim3(grid), dim3(NTHREADS), LDS_BYTES, stream, a); }
#else
    a.ph_lo = 0; a.ph_hi = NPHASES;
    void* args[] = {&a};
    hipError_t e = hipLaunchCooperativeKernel((const void*)hybrid_fwd, dim3(grid), dim3(NTHREADS), args, LDS_BYTES, stream);
    if (e != hipSuccess) fprintf(stderr, "kernel_launch: cooperative launch failed: %s (grid %d)\n", hipGetErrorString(e), grid);
#endif
}
```

```cpp
#include <hip/hip_runtime.h>
#include <hip/hip_cooperative_groups.h>
#include <cstdio>
#include <cstdint>
namespace cg = cooperative_groups;
namespace pg8 {
#define PG8_LAS __attribute__((address_space(3)))
typedef unsigned short bf16_t;
typedef short bf16x8 __attribute__((ext_vector_type(8)));
typedef float f32x4 __attribute__((ext_vector_type(4)));
typedef unsigned u32x4 __attribute__((ext_vector_type(4)));
constexpr int BM = 256, BK = 64, HALF = 128, HTB = HALF * BK * 2  , STAGE_BYTES = 8 * HTB, NXCD = 8, WGM = 8;

__host__ __device__ __forceinline__ int lds_byte(int r, int c) { const int st = (r >> 4) * 2 + (c >> 5), rr = r & 15, cc = c & 31, ob = rr * 64 + cc * 2; return st * 1024 + (ob ^ (((ob >> 9) & 1) << 5)); }
__host__ __device__ __forceinline__ void stage_rc(int b, int& R, int& C) { const int st = b / 1024, sb = b % 1024, swz = sb ^ (((sb >> 9) & 1) << 5); R = (st >> 1) * 16 + swz / 64; C = (st & 1) * 32 + (swz % 64) / 2; }
__host__ __device__ __forceinline__ int perm32(int rho) { const int n = rho >> 4, i = rho & 15; return 8 * (i >> 2) + 4 * n + (i & 3); }

struct Unit { int pm, pn; };
struct Gemm { const bf16_t* A; const bf16_t* Bt; int M, N, K; };

struct StaticOrder {
    int nM, nN, nwg, G, c;
    __host__ __device__ void init(int M, int N, int G_, int c_) { nM = M / BM; nN = N / BM; nwg = nM * nN; G = G_; c = c_; }
    __host__ __device__ bool next(int i, Unit& u) const {
        const long L = (long)i * G + c; if (L >= nwg) return false;
        int wgid = (int)L; { const int q = nwg / NXCD, r = nwg % NXCD, xcd = wgid % NXCD, off = wgid / NXCD; wgid = (xcd < r ? xcd * (q + 1) : r * (q + 1) + (xcd - r) * q) + off; }
        const int nig = WGM * nN, gid = wgid / nig, fm = gid * WGM, gsz = (nM - fm) < WGM ? (nM - fm) : WGM;
        u.pm = fm + ((wgid % nig) % gsz); u.pn = (wgid % nig) / gsz; return true;
    }
    __device__ __forceinline__ void a_ready(const Unit&) const {}
    __device__ __forceinline__ void done(const Unit&) const {}
};

__device__ __forceinline__ unsigned cvt_pk_bf16(float lo, float hi) { unsigned r; asm volatile("v_cvt_pk_bf16_f32 %0, %1, %2" : "=v"(r) : "v"(lo), "v"(hi)); return r; }
typedef float f32x2 __attribute__((ext_vector_type(2)));
__device__ __forceinline__ f32x2 gelu_pk(f32x2 v) {
    const f32x2 av = __builtin_elementwise_abs(v), d = av * 0.2316418882f + 1.0f;
    f32x2 t; t.x = __builtin_amdgcn_rcpf(d.x); t.y = __builtin_amdgcn_rcpf(d.y);
    f32x2 q = t * 0.5307027145f + (-0.7265760135f); q = q * t + 0.7107068705f; q = q * t + (-0.142248368f); q = q * t + 0.127414796f; q = q * t;
    const f32x2 s = (v * v) * (-0.72134752044f);
    f32x2 e; e.x = __builtin_amdgcn_exp2f(s.x); e.y = __builtin_amdgcn_exp2f(s.y);
    const f32x2 m = v * (q * e), r = v - m;
    f32x2 o; o.x = v.x < 0.f ? m.x : r.x; o.y = v.y < 0.f ? m.y : r.y; return o;
}

template <int ACT  > struct EpiBf16 {
    static constexpr bool PERM = true, AFTER_DRAIN = false; static_assert(ACT == 0 || ACT == 1, "EpiBf16: ACT is 0 (none) or 1 (gelu_pk)");
    bf16_t* O; int ldc; const float* bias; int split_cols; size_t split_stride; float scale0;
    __device__ __forceinline__ void operator()(const f32x4 (&acc)[2][2][4][2], const Unit& u, int wr, int wc, int fr, int fq) const {
        const int row0 = u.pm * BM + wr * 64 + fr; int colt = u.pn * BM; bf16_t* base = O;
        float sc = 1.f; if (split_cols) { const int t = colt / split_cols; base += (size_t)t * split_stride; colt -= t * split_cols; if (t == 0) sc = scale0; }
        const int col0 = colt + wc * 32 + 8 * fq, bcol0 = u.pn * BM + wc * 32 + 8 * fq;
        f32x4 bv[2][2];
#pragma unroll
        for (int bj = 0; bj < 2; ++bj)
#pragma unroll
            for (int n = 0; n < 2; ++n) bv[bj][n] = bias ? *(const f32x4*)(bias + bcol0 + bj * HALF + 4 * n) : (f32x4){0.f, 0.f, 0.f, 0.f};
#pragma unroll
        for (int ai = 0; ai < 2; ++ai)
#pragma unroll
            for (int m = 0; m < 4; ++m) { bf16_t* rowp = base + (size_t)(row0 + ai * HALF + m * 16) * ldc + col0;
#pragma unroll
                for (int bj = 0; bj < 2; ++bj) { f32x4 v0 = acc[ai][bj][m][0] + bv[bj][0], v1 = acc[ai][bj][m][1] + bv[bj][1];
                    if (ACT == 1) { f32x2 a = gelu_pk((f32x2){v0[0], v0[1]}), b = gelu_pk((f32x2){v0[2], v0[3]}), c = gelu_pk((f32x2){v1[0], v1[1]}), d = gelu_pk((f32x2){v1[2], v1[3]});
                        v0 = (f32x4){a.x, a.y, b.x, b.y}; v1 = (f32x4){c.x, c.y, d.x, d.y}; }
                    v0 = v0 * sc; v1 = v1 * sc; u32x4 w; w.x = cvt_pk_bf16(v0[0], v0[1]); w.y = cvt_pk_bf16(v0[2], v0[3]); w.z = cvt_pk_bf16(v1[0], v1[1]); w.w = cvt_pk_bf16(v1[2], v1[3]);
                    *(u32x4*)(rowp + bj * HALF) = w; } }
    }
};
template <class Epi, class Sched, bool ALIGN_EPI = false, bool SP2 = false>
__device__ __forceinline__ void gemm_phase(PG8_LAS unsigned char* lds, const Gemm g, const Sched& S, const Epi& E) {
    const int tid = threadIdx.x, wid = __builtin_amdgcn_readfirstlane(tid >> 6), lane = tid & 63, wr = wid >> 2, wc = wid & 3, fr = lane & 15, fq = lane >> 4;
    const int K = g.K, nt = K / BK;
    unsigned voffA[2], voffB[2];
#pragma unroll
    for (int i = 0; i < 2; ++i) { int R, C; stage_rc(tid * 16 + i * 8192, R, C); const int Rb = Epi::PERM ? ((R & ~31) + perm32(R & 31)) : R;
        voffA[i] = (unsigned)(R * K + C) * 2u; voffB[i] = (unsigned)(Rb * K + C) * 2u; }
    const size_t kstep = (size_t)(BK * 2);
    const size_t hstep = (size_t)HALF * K * 2;
    const size_t tstep = 2 * hstep;
    const unsigned ldsw = (unsigned)wid * 1024u;
    const int aoff = lds_byte(wr * 64 + fr, fq * 8), boff = lds_byte(wc * 32 + fr, fq * 8);
#define PG8_SA(b, h) (((b) * 2 + (h)) * HTB)
#define PG8_SB(b, h) ((4 + (b) * 2 + (h)) * HTB)
#define PG8_STAGE(bufoff, gbase, voff) do { _Pragma("unroll") for (int _i = 0; _i < 2; ++_i) \
        __builtin_amdgcn_global_load_lds((const unsigned*)((const char*)(gbase) + (voff)[_i]), (PG8_LAS unsigned*)(lds + (bufoff) + ldsw + _i * 8192), 16, 0, 0); } while (0)
#define PG8_LDA(dst, b, h) do { _Pragma("unroll") for (int m = 0; m < 4; ++m) _Pragma("unroll") for (int k = 0; k < 2; ++k) dst[m][k] = *(const PG8_LAS bf16x8*)(lds + PG8_SA(b, h) + aoff + m * 2048 + k * 1024); } while (0)
#define PG8_LDB(dst, b, h) do { _Pragma("unroll") for (int n = 0; n < 2; ++n) _Pragma("unroll") for (int k = 0; k < 2; ++k) dst[n][k] = *(const PG8_LAS bf16x8*)(lds + PG8_SB(b, h) + boff + n * 2048 + k * 1024); } while (0)
#define PG8_MMA(ai, bj, At, Bt) do { __builtin_amdgcn_s_setprio(1); _Pragma("unroll") for (int m = 0; m < 4; ++m) _Pragma("unroll") for (int n = 0; n < 2; ++n) _Pragma("unroll") for (int k = 0; k < 2; ++k) \
        acc[ai][bj][m][n] = __builtin_amdgcn_mfma_f32_16x16x32_bf16(Bt[n][k], At[m][k], acc[ai][bj][m][n], 0, 0, 0); __builtin_amdgcn_s_setprio(0); } while (0)
#define PG8_WAIT_V(n) asm volatile("s_waitcnt vmcnt(" #n ")" ::: "memory")
#define PG8_WAIT_L(n) asm volatile("s_waitcnt lgkmcnt(" #n ")" ::: "memory")
#define PG8_BAR __builtin_amdgcn_s_barrier()
#define PG8_SCHED __builtin_amdgcn_sched_barrier(0)
    Unit cur, nxt; int ui = 0;
    if (!S.next(0, cur)) return;
    f32x4 acc[2][2][4][2];
#pragma unroll
    for (int a = 0; a < 2; ++a)
#pragma unroll
        for (int b = 0; b < 2; ++b)
#pragma unroll
            for (int m = 0; m < 4; ++m)
#pragma unroll
                for (int n = 0; n < 2; ++n) acc[a][b][m][n] = (f32x4){0.f, 0.f, 0.f, 0.f};
    bf16x8 At[4][2], B0[2][2], B1[2][2];
    const char* cA = (const char*)g.A + (size_t)cur.pm * tstep; const char* cB = (const char*)g.Bt + (size_t)cur.pn * tstep;
    S.a_ready(cur);
    if constexpr (SP2) {
        PG8_STAGE(PG8_SB(0, 0), cB, voffB); PG8_STAGE(PG8_SB(0, 1), cB + hstep, voffB); PG8_STAGE(PG8_SA(0, 0), cA, voffA); PG8_STAGE(PG8_SA(0, 1), cA + hstep, voffA);
        if (wr == 1) PG8_BAR;
        PG8_WAIT_V(2); PG8_BAR;
        PG8_STAGE(PG8_SB(1, 0), cB + kstep, voffB); PG8_STAGE(PG8_SA(1, 0), cA + kstep, voffA); PG8_STAGE(PG8_SB(1, 1), cB + hstep + kstep, voffB);
        PG8_WAIT_V(6); PG8_BAR;
    } else {
        PG8_STAGE(PG8_SB(0, 0), cB, voffB); PG8_STAGE(PG8_SA(0, 0), cA, voffA); PG8_STAGE(PG8_SB(0, 1), cB + hstep, voffB); PG8_STAGE(PG8_SA(0, 1), cA + hstep, voffA);
        if (wr == 1) PG8_BAR;
        PG8_WAIT_V(4); PG8_BAR;
        PG8_STAGE(PG8_SB(1, 0), cB + kstep, voffB); PG8_STAGE(PG8_SA(1, 0), cA + kstep, voffA); PG8_STAGE(PG8_SB(1, 1), cB + hstep + kstep, voffB);
        PG8_WAIT_V(6); PG8_BAR;
    }
    for (;;) {
        const bool has_next = S.next(ui + 1, nxt);
        const char* nA = has_next ? (const char*)g.A + (size_t)nxt.pm * tstep : cA; const char* nB = has_next ? (const char*)g.Bt + (size_t)nxt.pn * tstep : cB;
        for (int t = 0; t < nt; t += 2) {
            const bool last = (t == nt - 2);
            const char* a1 = cA + (size_t)(t + 1) * kstep;
            const char* a2 = last ? nA : cA + (size_t)(t + 2) * kstep; const char* b2 = last ? nB : cB + (size_t)(t + 2) * kstep;
            const char* a3 = a2 + kstep; const char* b3 = b2 + kstep;
            if (last && has_next) S.a_ready(nxt);
            if constexpr (SP2) {
            PG8_LDB(B0, 0, 0); PG8_LDB(B1, 0, 1); PG8_SCHED; PG8_LDA(At, 0, 0); PG8_STAGE(PG8_SA(1, 1), a1 + hstep, voffA);
            PG8_WAIT_V(8); PG8_WAIT_L(0); PG8_BAR; PG8_MMA(0, 0, At, B0); PG8_MMA(0, 1, At, B1); PG8_BAR; PG8_SCHED;
            PG8_LDA(At, 0, 1); PG8_STAGE(PG8_SB(0, 0), b2, voffB); PG8_STAGE(PG8_SB(0, 1), b2 + hstep, voffB); PG8_STAGE(PG8_SA(0, 0), a2, voffA);
            PG8_WAIT_V(8); PG8_WAIT_L(0); PG8_BAR; PG8_MMA(1, 0, At, B0); PG8_MMA(1, 1, At, B1); PG8_BAR; PG8_SCHED;
            PG8_LDB(B0, 1, 0); PG8_LDB(B1, 1, 1); PG8_SCHED; PG8_LDA(At, 1, 0); PG8_STAGE(PG8_SA(0, 1), a2 + hstep, voffA);
            PG8_WAIT_V(8); PG8_WAIT_L(0); PG8_BAR; PG8_MMA(0, 0, At, B0); PG8_MMA(0, 1, At, B1); PG8_BAR; PG8_SCHED;
            PG8_LDA(At, 1, 1); PG8_STAGE(PG8_SB(1, 0), b3, voffB); PG8_STAGE(PG8_SB(1, 1), b3 + hstep, voffB); PG8_STAGE(PG8_SA(1, 0), a3, voffA);
            PG8_WAIT_V(8); PG8_WAIT_L(0); PG8_BAR; PG8_MMA(1, 0, At, B0); PG8_MMA(1, 1, At, B1); PG8_BAR; PG8_SCHED;
            } else {
            PG8_LDB(B0, 0, 0); PG8_SCHED; PG8_LDA(At, 0, 0); PG8_STAGE(PG8_SA(1, 1), a1 + hstep, voffA);
            PG8_WAIT_L(8); PG8_BAR; PG8_WAIT_L(0); PG8_MMA(0, 0, At, B0); PG8_BAR; PG8_SCHED;
            PG8_LDB(B1, 0, 1); PG8_STAGE(PG8_SB(0, 0), b2, voffB);
            PG8_BAR; PG8_WAIT_L(0); PG8_MMA(0, 1, At, B1); PG8_BAR;
            PG8_LDA(At, 0, 1); PG8_STAGE(PG8_SA(0, 0), a2, voffA);
            PG8_BAR; PG8_WAIT_L(0); PG8_MMA(1, 0, At, B0); PG8_BAR; PG8_SCHED;
            PG8_STAGE(PG8_SB(0, 1), b2 + hstep, voffB);
            PG8_WAIT_V(6); PG8_BAR; PG8_MMA(1, 1, At, B1); PG8_BAR;
            PG8_LDB(B0, 1, 0); PG8_SCHED; PG8_LDA(At, 1, 0); PG8_STAGE(PG8_SA(0, 1), a2 + hstep, voffA);
            PG8_WAIT_L(8); PG8_BAR; PG8_WAIT_L(0); PG8_MMA(0, 0, At, B0); PG8_BAR; PG8_SCHED;
            PG8_LDB(B1, 1, 1); PG8_STAGE(PG8_SB(1, 0), b3, voffB);
            PG8_BAR; PG8_WAIT_L(0); PG8_MMA(0, 1, At, B1); PG8_BAR;
            PG8_LDA(At, 1, 1); PG8_STAGE(PG8_SA(1, 0), a3, voffA);
            PG8_BAR; PG8_WAIT_L(0); PG8_MMA(1, 0, At, B0); PG8_BAR; PG8_SCHED;
            PG8_STAGE(PG8_SB(1, 1), b3 + hstep, voffB);
            PG8_WAIT_V(6); PG8_BAR; PG8_MMA(1, 1, At, B1); PG8_BAR;
            }
        }
        if constexpr (ALIGN_EPI) { if (wr == 0) PG8_BAR; }
        if constexpr (!Epi::AFTER_DRAIN) { E(acc, cur, wr, wc, fr, fq); S.done(cur); }
        if (!has_next) break;
#pragma unroll
        for (int a = 0; a < 2; ++a)
#pragma unroll
            for (int b = 0; b < 2; ++b)
#pragma unroll
                for (int m = 0; m < 4; ++m)
#pragma unroll
                    for (int n = 0; n < 2; ++n) acc[a][b][m][n] = (f32x4){0.f, 0.f, 0.f, 0.f};
        cur = nxt; cA = nA; cB = nB; ++ui;
        if constexpr (ALIGN_EPI) { if (wr == 1) PG8_BAR; }
    }
    PG8_WAIT_V(0);
    if constexpr (!ALIGN_EPI) { if (wr == 0) PG8_BAR; }
    PG8_BAR;
    if constexpr (Epi::AFTER_DRAIN) { E.fused(acc, cur, wr, wc, fr, fq, lds, wid, lane); S.done(cur); }
#undef PG8_SA
#undef PG8_SB
#undef PG8_STAGE
#undef PG8_LDA
#undef PG8_LDB
#undef PG8_MMA
#undef PG8_WAIT_V
#undef PG8_WAIT_L
#undef PG8_BAR
#undef PG8_SCHED
}
}
#ifndef PG8_SP2
#define PG8_SP2 true
#endif
#ifndef PG8_ALIGN
#define PG8_ALIGN true
#endif

constexpr int NB = 8, SEQ = 4096, DM = 1024, MTOK = NB * SEQ;
constexpr int SWA_QKV = 1280, DIFF_QKV = 3072, DFF = 2816, DUP = 2 * DFF;
constexpr float EPS = 1e-6f;
constexpr float LOG2E = 1.4426950408889634f;
constexpr float C2 = 0.125f * LOG2E;
constexpr float LAMBDA_INIT1 = 0.35550906759096926f;

#define LAS __attribute__((address_space(3)))
typedef unsigned short bf16;
typedef float f32x4 __attribute__((ext_vector_type(4)));
typedef float f32x16 __attribute__((ext_vector_type(16)));
typedef short bf16x8 __attribute__((ext_vector_type(8)));
typedef short s16x4 __attribute__((ext_vector_type(4)));
typedef unsigned u32x4 __attribute__((ext_vector_type(4)));
typedef unsigned u32x2 __attribute__((ext_vector_type(2)));

constexpr int NWAVES = 8, NTHREADS = 512;
constexpr int LDS_BYTES = 135168;

constexpr size_t MiB = 1u << 20;
constexpr size_t WS_WQKV0 = 0;
constexpr size_t WS_WO0   = 3 * MiB;
constexpr size_t WS_WQKV1 = 5 * MiB;
constexpr size_t WS_WO1   = 11 * MiB;
constexpr size_t WS_WUP0  = 13 * MiB;
constexpr size_t WS_WUP1  = 24 * MiB;
constexpr size_t WS_WDN0  = 35 * MiB;
constexpr size_t WS_WDN1  = 41 * MiB;
constexpr size_t WS_H     = 48 * MiB;
constexpr size_t WS_QKV   = 112 * MiB;
constexpr size_t WS_AO    = 304 * MiB;
constexpr size_t WS_MO    = 368 * MiB;
constexpr size_t WS_UG    = 112 * MiB;
constexpr size_t WS_UV    = 288 * MiB;
constexpr size_t WS_HALO  = 464 * MiB;
constexpr size_t WS_CTL   = 488 * MiB;
constexpr size_t CTL_BYTES = 16384;
constexpr size_t WS_END   = 489 * MiB;

__device__ __forceinline__ unsigned f2bf(float f) { unsigned u = __builtin_bit_cast(unsigned, f); return (u + 0x7fffu + ((u >> 16) & 1u)) >> 16; }
__device__ __forceinline__ unsigned pk2(float lo, float hi) { return f2bf(lo) | (f2bf(hi) << 16); }
__device__ __forceinline__ float bf2f(unsigned short b) { return __builtin_bit_cast(float, (unsigned)b << 16); }
__device__ __forceinline__ float bflo(unsigned w) { return __builtin_bit_cast(float, w << 16); }
__device__ __forceinline__ float bfhi(unsigned w) { return __builtin_bit_cast(float, w & 0xffff0000u); }
__device__ __forceinline__ float wave_sum(float v) {
#pragma unroll
    for (int o = 1; o < 64; o <<= 1) v += __shfl_xor(v, o);
    return v;
}

struct Args {
    const float* x; const float* mix_pre_g; const float* mix_post_g; const float* ffn_pre_g; const float* ffn_post_g;
    const float* swa_w_qkv; const float* swa_sinks; const float* swa_w_o;
    const float* diff_w_qkv; const float* lq1; const float* lk1; const float* lq2; const float* lk2; const float* subln_g; const float* diff_w_o;
    const float* w_up; const float* conv_w; const float* conv_b; const float* w_down;
    float* out; unsigned char* ws; int ph_lo, ph_hi;
};

__device__ __forceinline__ void transpose_item(const float* W, int K, int N, bf16* WT, LAS float* scr, int item, int lane) {
    const int nblk = N / 32, kb = item / nblk, nb = item % nblk, k0 = 64 * kb, n0 = 32 * nb;
#pragma unroll 8
    for (int i = 0; i < 32; ++i) { const int kk = 2 * i + (lane >> 5); scr[kk * 33 + (lane & 31)] = W[(size_t)(k0 + kk) * N + n0 + (lane & 31)]; }
    asm volatile("s_waitcnt lgkmcnt(0)" ::: "memory");
    const int c = lane & 7;
#pragma unroll
    for (int j = 0; j < 4; ++j) { const int n = (lane >> 3) + 8 * j; const LAS float* s = scr + (8 * c) * 33 + n;
        u32x4 o; o.x = pk2(s[0 * 33], s[1 * 33]); o.y = pk2(s[2 * 33], s[3 * 33]); o.z = pk2(s[4 * 33], s[5 * 33]); o.w = pk2(s[6 * 33], s[7 * 33]);
        *(u32x4*)(WT + (size_t)(n0 + n) * K + k0 + 8 * c) = o; }
    asm volatile("s_waitcnt lgkmcnt(0)" ::: "memory");
}

template <int MODE>
__device__ __forceinline__ void norm_rows(const float* xin, const bf16* mrow, const float* gpost, const float* gnext, float* xout, bf16* hout, int gw, int ngw, int lane) {
    for (int row = gw; row < MTOK; row += ngw) {
        const f32x4* xr = (const f32x4*)(xin + (size_t)row * DM) + lane;
        f32x4 v[4];
#pragma unroll
        for (int j = 0; j < 4; ++j) v[j] = xr[64 * j];
        if (MODE == 1) {
            const u32x2* mr = (const u32x2*)(mrow + (size_t)row * DM) + lane;
            f32x4 mv[4]; float s = 0.f;
#pragma unroll
            for (int j = 0; j < 4; ++j) { const u32x2 w = mr[64 * j]; mv[j] = (f32x4){bflo(w.x), bfhi(w.x), bflo(w.y), bfhi(w.y)};
                s += (mv[j].x * mv[j].x + mv[j].y * mv[j].y) + (mv[j].z * mv[j].z + mv[j].w * mv[j].w); }
            const float rs = 1.0f / sqrtf(wave_sum(s) * (1.f / DM) + EPS);
            f32x4* xo = (f32x4*)(xout + (size_t)row * DM) + lane;
#pragma unroll
            for (int j = 0; j < 4; ++j) { const f32x4 g = ((const f32x4*)gpost)[lane + 64 * j]; v[j] = v[j] + mv[j] * rs * g; xo[64 * j] = v[j]; }
        }
        if (MODE == 0 || gnext != nullptr) {
            const float* gg = (MODE == 0) ? gpost : gnext;
            float s = 0.f;
#pragma unroll
            for (int j = 0; j < 4; ++j) s += (v[j].x * v[j].x + v[j].y * v[j].y) + (v[j].z * v[j].z + v[j].w * v[j].w);
            const float rs = 1.0f / sqrtf(wave_sum(s) * (1.f / DM) + EPS);
            u32x2* ho = (u32x2*)(hout + (size_t)row * DM) + lane;
#pragma unroll
            for (int j = 0; j < 4; ++j) { const f32x4 g = ((const f32x4*)gg)[lane + 64 * j]; const f32x4 y = v[j] * rs * g; u32x2 w; w.x = pk2(y.x, y.y); w.y = pk2(y.z, y.w); ho[64 * j] = w; }
        }
    }
}

__device__ __forceinline__ float gelu_tanh(float g) {
    const float z = 0.7978845608028654f * (g + 0.044715f * g * g * g);
    const float e = __builtin_amdgcn_exp2f(-2.0f * LOG2E * z);
    return g * __builtin_amdgcn_rcpf(1.0f + e);
}
__device__ __forceinline__ void unpack8(const u32x4 w, float* f) { f[0] = bflo(w.x); f[1] = bfhi(w.x); f[2] = bflo(w.y); f[3] = bfhi(w.y); f[4] = bflo(w.z); f[5] = bfhi(w.z); f[6] = bflo(w.w); f[7] = bfhi(w.w); }
constexpr int CONV_RUN = 16;
__device__ __forceinline__ void conv_gelu_phase(bf16* UG, const bf16* UV, const bf16* HALO, const float* cw, const float* cb, int gtid, int ngt) {
    constexpr int NCH = DFF / 8;
    constexpr int NTASK = NCH * (MTOK / CONV_RUN);
    for (int task = gtid; task < NTASK; task += ngt) {
        const int ch = task % NCH, run = task / NCH, t0 = run * CONV_RUN, c0 = ch * 8;
        float wg[3][8], wv[3][8], bg[8], bv[8];
#pragma unroll
        for (int tap = 0; tap < 3; ++tap) {
            const f32x4 a = *(const f32x4*)(cw + tap * DUP + c0), b = *(const f32x4*)(cw + tap * DUP + c0 + 4);
            const f32x4 c = *(const f32x4*)(cw + tap * DUP + DFF + c0), d = *(const f32x4*)(cw + tap * DUP + DFF + c0 + 4);
#pragma unroll
            for (int k = 0; k < 4; ++k) { wg[tap][k] = a[k]; wg[tap][4 + k] = b[k]; wv[tap][k] = c[k]; wv[tap][4 + k] = d[k]; }
        }
        { const f32x4 a = *(const f32x4*)(cb + c0), b = *(const f32x4*)(cb + c0 + 4), c = *(const f32x4*)(cb + DFF + c0), d = *(const f32x4*)(cb + DFF + c0 + 4);
#pragma unroll
          for (int k = 0; k < 4; ++k) { bg[k] = a[k]; bg[4 + k] = b[k]; bv[k] = c[k]; bv[4 + k] = d[k]; } }
        float g2[8], g1[8], v2[8], v1[8];
        const bool seq_start = (t0 % SEQ) == 0;
        if (seq_start) {
#pragma unroll
            for (int k = 0; k < 8; ++k) { g2[k] = 0.f; g1[k] = 0.f; v2[k] = 0.f; v1[k] = 0.f; }
        } else {
            unpack8(*(const u32x4*)(HALO + (size_t)((run - 1) * 2 + 0) * DFF + c0), g2); unpack8(*(const u32x4*)(HALO + (size_t)((run - 1) * 2 + 1) * DFF + c0), g1);
            unpack8(*(const u32x4*)(UV + (size_t)(t0 - 2) * DFF + c0), v2); unpack8(*(const u32x4*)(UV + (size_t)(t0 - 1) * DFF + c0), v1);
        }
#pragma unroll 4
        for (int t = 0; t < CONV_RUN; ++t) {
            float g0[8], v0[8];
            unpack8(*(const u32x4*)(UG + (size_t)(t0 + t) * DFF + c0), g0); unpack8(*(const u32x4*)(UV + (size_t)(t0 + t) * DFF + c0), v0);
            float r[8];
#pragma unroll
            for (int k = 0; k < 8; ++k) {
                const float cgv = bg[k] + wg[0][k] * g2[k] + wg[1][k] * g1[k] + wg[2][k] * g0[k];
                const float cvv = bv[k] + wv[0][k] * v2[k] + wv[1][k] * v1[k] + wv[2][k] * v0[k];
                r[k] = gelu_tanh(cgv) * cvv;
                g2[k] = g1[k]; g1[k] = g0[k]; v2[k] = v1[k]; v1[k] = v0[k];
            }
            u32x4 o; o.x = pk2(r[0], r[1]); o.y = pk2(r[2], r[3]); o.z = pk2(r[4], r[5]); o.w = pk2(r[6], r[7]);
            *(u32x4*)(UG + (size_t)(t0 + t) * DFF + c0) = o;
        }
    }
}

struct EpiUp {
    static constexpr bool PERM = true, AFTER_DRAIN = false;
    bf16* UG; bf16* UV; bf16* HALO;
    __device__ __forceinline__ void operator()(const pg8::f32x4 (&acc)[2][2][4][2], const pg8::Unit& u, int wr, int wc, int fr, int fq) const {
        const int row0 = u.pm * 256 + wr * 64 + fr; int colt = u.pn * 256; bf16* base = UG; bool gate = true;
        if (colt >= DFF) { colt -= DFF; base = UV; gate = false; }
        const int col0 = colt + wc * 32 + 8 * fq;
#pragma unroll
        for (int ai = 0; ai < 2; ++ai)
#pragma unroll
            for (int m = 0; m < 4; ++m) { const int row = row0 + ai * 128 + m * 16; bf16* rowp = base + (size_t)row * DFF + col0;
#pragma unroll
                for (int bj = 0; bj < 2; ++bj) { const pg8::f32x4 v0 = acc[ai][bj][m][0], v1 = acc[ai][bj][m][1];
                    u32x4 w; w.x = pg8::cvt_pk_bf16(v0[0], v0[1]); w.y = pg8::cvt_pk_bf16(v0[2], v0[3]); w.z = pg8::cvt_pk_bf16(v1[0], v1[1]); w.w = pg8::cvt_pk_bf16(v1[2], v1[3]);
                    *(u32x4*)(rowp + bj * 128) = w;
                    if (gate && fr >= 14) *(u32x4*)(HALO + (size_t)((row >> 4) * 2 + (fr - 14)) * DFF + col0 + bj * 128) = w; } }
    }
};

typedef short v4i16_t __attribute__((ext_vector_type(4)));
__device__ __forceinline__ int pi32(int r) { return (r & ~12) | ((r & 4) << 1) | ((r & 8) >> 1); }
__device__ __forceinline__ s16x4 tr_read(LAS const unsigned char* p) { return __builtin_bit_cast(s16x4, __builtin_amdgcn_ds_read_tr16_b64_v4i16((LAS v4i16_t*)p)); }

template <int NDB, int VP>
__device__ __forceinline__ void attn_block(f32x16 (&o)[NDB], float& m, float& l, const bf16x8 (&qf)[4], LAS const unsigned char* kp, LAS const unsigned char* vp,
                                           int rel0, float slope2, bool mask, int window) {
    f32x16 s = {};
#pragma unroll
    for (int ks = 0; ks < 4; ++ks) { const bf16x8 kf = *(LAS const bf16x8*)(kp + ks * 32); s = __builtin_amdgcn_mfma_f32_32x32x16_bf16(kf, qf[ks], s, 0, 0, 0); }
    const float base = slope2 * (float)rel0;
#pragma unroll
    for (int i = 0; i < 16; ++i) { const int off = (i & 7) + 16 * (i >> 3); s[i] = fmaf(s[i], C2, fmaf(slope2, (float)off, base)); }
    if (mask) {
#pragma unroll
        for (int i = 0; i < 16; ++i) { const int rel = rel0 + (i & 7) + 16 * (i >> 3); if (rel > 0 || rel <= -window) s[i] = -INFINITY; }
    }
    float mx = fmaxf(fmaxf(s[0], s[1]), fmaxf(s[2], s[3]));
#pragma unroll
    for (int i = 4; i < 16; i += 4) mx = fmaxf(mx, fmaxf(fmaxf(s[i], s[i + 1]), fmaxf(s[i + 2], s[i + 3])));
    mx = fmaxf(mx, __shfl_xor(mx, 32));
    const float mn = fmaxf(m, mx);
    const float alpha = __builtin_amdgcn_exp2f(m - mn);
    m = mn;
    float ls = 0.f;
#pragma unroll
    for (int i = 0; i < 16; ++i) { s[i] = __builtin_amdgcn_exp2f(s[i] - mn); ls += s[i]; }
    l = l * alpha + ls;
    if (!__all(alpha == 1.0f)) {
#pragma unroll
        for (int db = 0; db < NDB; ++db)
#pragma unroll
            for (int i = 0; i < 16; ++i) o[db][i] *= alpha;
    }
    bf16x8 pf[2];
#pragma unroll
    for (int ss = 0; ss < 2; ++ss) { u32x4 w; w.x = pg8::cvt_pk_bf16(s[8 * ss + 0], s[8 * ss + 1]); w.y = pg8::cvt_pk_bf16(s[8 * ss + 2], s[8 * ss + 3]);
        w.z = pg8::cvt_pk_bf16(s[8 * ss + 4], s[8 * ss + 5]); w.w = pg8::cvt_pk_bf16(s[8 * ss + 6], s[8 * ss + 7]); pf[ss] = __builtin_bit_cast(bf16x8, w); }
#pragma unroll
    for (int ss = 0; ss < 2; ++ss)
#pragma unroll
        for (int db = 0; db < NDB; ++db) {
            LAS const unsigned char* a = vp + (16 * ss) * VP + db * 64;
            const s16x4 lo = tr_read(a), hi4 = tr_read(a + 4 * VP);
            const bf16x8 vf = (bf16x8){lo[0], lo[1], lo[2], lo[3], hi4[0], hi4[1], hi4[2], hi4[3]};
            o[db] = __builtin_amdgcn_mfma_f32_32x32x16_bf16(vf, pf[ss], o[db], 0, 0, 0);
        }
}

__device__ __forceinline__ void swa_attn_phase(LAS unsigned char* lds, const bf16* QKV, bf16* AO, const float* sinks, int tid, int lane, int wave) {
    constexpr int KP = 144, VP = 192, KBYTES = 256 * KP;
    const int r32 = lane & 31, hi = lane >> 5;
    LAS const unsigned char* kbase = lds + pi32(r32) * KP + hi * 16;
    LAS const unsigned char* vbase = lds + KBYTES + (8 * hi + ((lane & 15) >> 2)) * VP + (16 * ((lane >> 4) & 1) + 4 * (lane & 3)) * 2;
    for (int u = blockIdx.x; u < NB * 2 * 32; u += gridDim.x) {
        const int b = u >> 6, kvh = (u >> 5) & 1, n = u & 31, hq = kvh * 8 + wave;
        const int j0 = (n == 0) ? 128 : 0;
        const size_t rowbase = (size_t)b * SEQ;
#pragma unroll
        for (int i = 0; i < 4; ++i) {
            const int cidx = tid + 512 * i, row = cidx >> 3, ch = cidx & 7;
            if (row >= j0) {
                const bf16* g = QKV + (rowbase + (size_t)(n * 128 - 128 + row)) * SWA_QKV + 1024 + kvh * 64 + ch * 8;
                const u32x4 kv = *(const u32x4*)g, vv = *(const u32x4*)(g + 128);
                *(LAS u32x4*)(lds + row * KP + ch * 16) = kv; *(LAS u32x4*)(lds + KBYTES + row * VP + ch * 16) = vv;
            }
        }
        __syncthreads();
        const float slope2 = exp2f(-0.5f * (float)(hq + 1)) * LOG2E;
        const float sink2 = sinks[hq] * LOG2E;
        for (int qb = 0; qb < 4; ++qb) {
            const int Q0 = n * 128 + 32 * qb;
            const bf16* qptr = QKV + (rowbase + (size_t)(Q0 + r32)) * SWA_QKV + hq * 64 + hi * 8;
            bf16x8 qf[4];
#pragma unroll
            for (int ks = 0; ks < 4; ++ks) qf[ks] = *(const bf16x8*)(qptr + ks * 16);
            f32x16 o[2]; o[0] = f32x16{}; o[1] = f32x16{};
            float m = -1e30f, l = 0.f;
            for (int k = 0; k < 5; ++k) {
                const int kb_abs = Q0 - 32 * k; if (kb_abs < 0) break;
                const int trow = 128 + 32 * qb - 32 * k;
                attn_block<2, VP>(o, m, l, qf, kbase + trow * KP, vbase + trow * VP, kb_abs + 8 * hi - (Q0 + r32), slope2, (k == 0 || k == 4), 128);
            }
            const float lt = l + __shfl_xor(l, 32) + __builtin_amdgcn_exp2f(sink2 - m);
            const float inv = 1.0f / lt;
            bf16* op = AO + (rowbase + (size_t)(Q0 + r32)) * DM + hq * 64 + 4 * hi;
#pragma unroll
            for (int db = 0; db < 2; ++db)
#pragma unroll
                for (int a = 0; a < 4; ++a) { u32x2 w; w.x = pk2(o[db][4 * a] * inv, o[db][4 * a + 1] * inv); w.y = pk2(o[db][4 * a + 2] * inv, o[db][4 * a + 3] * inv);
                    *(u32x2*)(op + 32 * db + 8 * a) = w; }
        }
        __syncthreads();
    }
}

__device__ __forceinline__ void diff_attn_phase(LAS unsigned char* lds, const bf16* QKV, bf16* AO, const float* lq1, const float* lk1, const float* lq2, const float* lk2, const float* subg,
                                                int tid, int lane, int wave) {
    constexpr int KP = 272, VP = 320, KBYTES = 64 * KP, STAGE = KBYTES + 64 * VP;
    const int r32 = lane & 31, hi = lane >> 5, rg = wave & 3, c = wave >> 2;
    const float lam = expf(wave_sum(lq1[lane] * lk1[lane])) - expf(wave_sum(lq2[lane] * lk2[lane])) + LAMBDA_INIT1;
    const int koff = pi32(r32) * KP + c * 128 + hi * 16;
    const int voff = KBYTES + (8 * hi + ((lane & 15) >> 2)) * VP + (16 * ((lane >> 4) & 1) + 4 * (lane & 3)) * 2;
    const int srow0 = tid >> 4, sch = tid & 15;
    for (int p = blockIdx.x; p < 1024; p += gridDim.x) {
        const int bh = p >> 4, sidx = p & 15, b = bh >> 3, h = bh & 7;
        const size_t rowbase = (size_t)b * SEQ;
        const float slope2 = exp2f(-(float)(h + 1)) * LOG2E;
        for (int which = 0; which < 2; ++which) {
            const int qblk = which ? 31 - sidx : sidx;
            const int qrow0 = qblk * 128 + rg * 32;
            const bf16* qptr = QKV + (rowbase + (size_t)(qrow0 + r32)) * DIFF_QKV + (h * 2 + c) * 64 + hi * 8;
            bf16x8 qf[4];
#pragma unroll
            for (int ks = 0; ks < 4; ++ks) qf[ks] = *(const bf16x8*)(qptr + ks * 16);
            f32x16 o[4];
#pragma unroll
            for (int db = 0; db < 4; ++db) o[db] = f32x16{};
            float m = -1e30f, l = 0.f;
            const int ntiles = 2 * qblk + 2;
            const bf16* gk = QKV + (rowbase + (size_t)srow0) * DIFF_QKV + 1024 + h * 128 + sch * 8;
            u32x4 kr[2], vr[2];
            {   const bf16* g = gk + (size_t)((ntiles - 1) * 64) * DIFF_QKV;
#pragma unroll
                for (int i = 0; i < 2; ++i) { kr[i] = *(const u32x4*)(g + (size_t)(32 * i) * DIFF_QKV); vr[i] = *(const u32x4*)(g + (size_t)(32 * i) * DIFF_QKV + 1024); } }
            for (int t = ntiles - 1; t >= 0; --t) {
                LAS unsigned char* st = lds + (t & 1) * STAGE;
#pragma unroll
                for (int i = 0; i < 2; ++i) { *(LAS u32x4*)(st + (srow0 + 32 * i) * KP + sch * 16) = kr[i]; *(LAS u32x4*)(st + KBYTES + (srow0 + 32 * i) * VP + sch * 16) = vr[i]; }
                __syncthreads();
                if (t > 0) { const bf16* g = gk + (size_t)((t - 1) * 64) * DIFF_QKV;
#pragma unroll
                    for (int i = 0; i < 2; ++i) { kr[i] = *(const u32x4*)(g + (size_t)(32 * i) * DIFF_QKV); vr[i] = *(const u32x4*)(g + (size_t)(32 * i) * DIFF_QKV + 1024); } }
#pragma unroll
                for (int blk = 1; blk >= 0; --blk) {
                    const int kb_abs = t * 64 + blk * 32;
                    if (kb_abs > qrow0 + 31) continue;
                    attn_block<4, VP>(o, m, l, qf, st + koff + blk * 32 * KP, st + voff + blk * 32 * VP, kb_abs + 8 * hi - (qrow0 + r32), slope2, kb_abs + 31 > qrow0, 1 << 30);
                }
            }
            const float inv = 1.0f / (l + __shfl_xor(l, 32));
            __syncthreads();
            LAS float* xch = (LAS float*)lds;
            if (c == 1) {
#pragma unroll
                for (int db = 0; db < 4; ++db)
#pragma unroll
                    for (int i = 0; i < 16; ++i) { const int d = 32 * db + (i & 3) + 8 * (i >> 2) + 4 * hi; xch[(rg * 128 + d) * 32 + r32] = o[db][i] * inv; }
            }
            __syncthreads();
            if (c == 0) {
                float ssq = 0.f;
#pragma unroll
                for (int db = 0; db < 4; ++db)
#pragma unroll
                    for (int i = 0; i < 16; ++i) { const int d = 32 * db + (i & 3) + 8 * (i >> 2) + 4 * hi; const float v = o[db][i] * inv - lam * xch[(rg * 128 + d) * 32 + r32]; o[db][i] = v; ssq += v * v; }
                ssq += __shfl_xor(ssq, 32);
                const float rs = (1.0f - LAMBDA_INIT1) / sqrtf(ssq * (1.0f / 128.0f) + EPS);
                bf16* op = AO + (rowbase + (size_t)(qrow0 + r32)) * DM + h * 128 + 4 * hi;
#pragma unroll
                for (int db = 0; db < 4; ++db)
#pragma unroll
                    for (int a = 0; a < 4; ++a) { const f32x4 g = *(const f32x4*)(subg + 32 * db + 8 * a + 4 * hi);
                        u32x2 w; w.x = pk2(o[db][4 * a] * rs * g.x, o[db][4 * a + 1] * rs * g.y); w.y = pk2(o[db][4 * a + 2] * rs * g.z, o[db][4 * a + 3] * rs * g.w);
                        *(u32x2*)(op + 32 * db + 8 * a) = w; }
            }
            __syncthreads();
        }
    }
}

#define XB_TMO      128
#define XB_XCNT(j)  (256  + 64 * (j))
#define XB_XSUB(j)  (1280 + 64 * (j))
#define XB_XGEN(j)  (2304 + 64 * (j))
#define XB_TOP      3328
#define XB_TOPGEN   3392
#define XCD_BAR_WORDS 3456
#define XB_SPIN_CAP (1u << 18)

__device__ __forceinline__ unsigned xb_ld(unsigned* p)              { return __hip_atomic_load(p, __ATOMIC_RELAXED, __HIP_MEMORY_SCOPE_AGENT); }
__device__ __forceinline__ unsigned xb_add(unsigned* p, unsigned v) { return __hip_atomic_fetch_add(p, v, __ATOMIC_RELAXED, __HIP_MEMORY_SCOPE_AGENT); }
__device__ __forceinline__ unsigned xb_xcc_id() { return (unsigned)__builtin_amdgcn_s_getreg((3 << 11) | 20) & 0xFu; }
#define XB_SPIN(cond, bar) do { unsigned _sp = 0; while (cond) { __builtin_amdgcn_s_sleep(1); \
    if ((++_sp & 255u) == 0u) { if (xb_ld(&(bar)[XB_TMO])) break; if (_sp > XB_SPIN_CAP) { atomicAdd(&(bar)[XB_TMO], 1u); break; } } } } while (0)

struct XcdBarrier {
    unsigned* bar; unsigned x;
    volatile LAS unsigned* st;
};

__device__ __forceinline__ XcdBarrier xcd_barrier_post(unsigned* bar, volatile LAS unsigned* st) {
    XcdBarrier b; b.bar = bar; b.x = xb_xcc_id(); b.st = st;
    if (threadIdx.x == 0) (void)xb_add(&bar[XB_XCNT(b.x)], 1u);
    return b;
}
__device__ __forceinline__ void xcd_barrier_complete(unsigned* bar, unsigned x, unsigned& nloc, unsigned& nx) {
    const unsigned G = gridDim.x * gridDim.y * gridDim.z;
    unsigned sum, cnt, mine, sp = 0u;
    for (;;) {
        sum = 0u; cnt = 0u; mine = 0u;
#pragma unroll
        for (unsigned j = 0; j < 16; ++j) { const unsigned c = xb_ld(&bar[XB_XCNT(j)]); sum += c; cnt += (c > 0u) ? 1u : 0u; mine = (j == x) ? c : mine; }
        if (sum == G) break;
        __builtin_amdgcn_s_sleep(1);
        if ((++sp & 255u) == 0u) { if (xb_ld(&bar[XB_TMO])) break; if (sp > XB_SPIN_CAP) { atomicAdd(&bar[XB_TMO], 1u); break; } }
    }
    nloc = mine > 0u ? mine : 1u; nx = cnt > 0u ? cnt : 1u;
}

__device__ __forceinline__ void xcd_barrier(const XcdBarrier& b) {
    asm volatile("s_waitcnt vmcnt(0)" ::: "memory");
    __syncthreads();
    if (threadIdx.x == 0) {
        unsigned* bar = b.bar;
        __builtin_amdgcn_s_waitcnt(0);
        unsigned nloc = b.st[0], nx = b.st[1];
        if (nloc == 0u) { xcd_barrier_complete(bar, b.x, nloc, nx); b.st[0] = nloc; b.st[1] = nx; }
        const unsigned old = xb_add(&bar[XB_XSUB(b.x)], 1u);
        const unsigned gen = old / nloc;
        if (old + 1u == (gen + 1u) * nloc) {
            __builtin_amdgcn_fence(__ATOMIC_RELEASE, "agent");
            asm volatile("s_waitcnt vmcnt(0)" ::: "memory");
            const unsigned og = xb_add(&bar[XB_TOP], 1u);
            const unsigned tg = og / nx;
            if (og + 1u == (tg + 1u) * nx) xb_add(&bar[XB_TOPGEN], 1u);
            else XB_SPIN(xb_ld(&bar[XB_TOPGEN]) == tg, bar);
            __builtin_amdgcn_fence(__ATOMIC_ACQUIRE, "agent");
            xb_add(&bar[XB_XGEN(b.x)], 1u);
            asm volatile("s_waitcnt vmcnt(0)" ::: "memory");
        } else {
            XB_SPIN(xb_ld(&bar[XB_XGEN(b.x)]) == gen, bar);
            __builtin_amdgcn_fence(__ATOMIC_ACQUIRE, "agent");
            asm volatile("s_waitcnt vmcnt(0)" ::: "memory");
        }
    }
    __syncthreads();
}

__global__ void __launch_bounds__(NTHREADS, 2) hybrid_fwd(Args a) {
    extern __shared__ __attribute__((aligned(16))) unsigned char lds_raw[];
    LAS unsigned char* lds = (LAS unsigned char*)lds_raw;
    const int tid = threadIdx.x, lane = tid & 63, wave = __builtin_amdgcn_readfirstlane(tid >> 6);
    const int G = gridDim.x, gw = blockIdx.x * NWAVES + wave, ngw = G * NWAVES;
    unsigned char* ws = a.ws;
    bf16* Wqkv0 = (bf16*)(ws + WS_WQKV0); bf16* Wo0 = (bf16*)(ws + WS_WO0); bf16* Wqkv1 = (bf16*)(ws + WS_WQKV1); bf16* Wo1 = (bf16*)(ws + WS_WO1);
    bf16* Wup[2] = {(bf16*)(ws + WS_WUP0), (bf16*)(ws + WS_WUP1)}; bf16* Wdn[2] = {(bf16*)(ws + WS_WDN0), (bf16*)(ws + WS_WDN1)};
    bf16* H = (bf16*)(ws + WS_H); bf16* QKV = (bf16*)(ws + WS_QKV); bf16* AO = (bf16*)(ws + WS_AO); bf16* MO = (bf16*)(ws + WS_MO);
    bf16* UG = (bf16*)(ws + WS_UG); bf16* UV = (bf16*)(ws + WS_UV); bf16* HALO = (bf16*)(ws + WS_HALO);
    const int lo = a.ph_lo, hi = a.ph_hi;
    { LAS unsigned* misc = (LAS unsigned*)(lds + 131072); if (tid < 4) misc[tid] = 0u; }
    __syncthreads();
    const XcdBarrier xbar = xcd_barrier_post((unsigned*)(ws + WS_CTL), (volatile LAS unsigned*)(lds + 131072));
#define IN(k) (lo <= (k) && (k) < hi)
#define SEAM(k) do { if (IN(k) && IN((k) + 1)) { if ((k) == 0) cg::this_grid().sync(); else xcd_barrier(xbar); } } while (0)
#define GEMM_BF16(Aptr, Btptr, Nn, Kk, Optr) do { pg8::Gemm g{(const pg8::bf16_t*)(Aptr), (const pg8::bf16_t*)(Btptr), MTOK, (Nn), (Kk)}; pg8::StaticOrder S; S.init(MTOK, (Nn), G, (int)blockIdx.x); \
        pg8::EpiBf16<0> E{(pg8::bf16_t*)(Optr), (Nn), nullptr, 0, 0, 1.f}; pg8::gemm_phase<pg8::EpiBf16<0>, pg8::StaticOrder, PG8_ALIGN, PG8_SP2>(lds, g, S, E); } while (0)

    if (IN(0)) {
        LAS float* scr = (LAS float*)(lds + wave * 16384);
        constexpr int I0 = (DM / 64) * (SWA_QKV / 32), I1 = (DM / 64) * (DM / 32), I2 = (DM / 64) * (DIFF_QKV / 32), I3 = I1, I4 = (DM / 64) * (DUP / 32), I5 = I4, I6 = (DFF / 64) * (DM / 32), I7 = I6;
        constexpr int NIT = I0 + I1 + I2 + I3 + I4 + I5 + I6 + I7;
        for (int it = gw; it < NIT; it += ngw) {
            int r = it;
            if (r < I0) { transpose_item(a.swa_w_qkv, DM, SWA_QKV, Wqkv0, scr, r, lane); continue; } r -= I0;
            if (r < I1) { transpose_item(a.swa_w_o, DM, DM, Wo0, scr, r, lane); continue; } r -= I1;
            if (r < I2) { transpose_item(a.diff_w_qkv, DM, DIFF_QKV, Wqkv1, scr, r, lane); continue; } r -= I2;
            if (r < I3) { transpose_item(a.diff_w_o, DM, DM, Wo1, scr, r, lane); continue; } r -= I3;
            if (r < I4) { transpose_item(a.w_up, DM, DUP, Wup[0], scr, r, lane); continue; } r -= I4;
            if (r < I5) { transpose_item(a.w_up + (size_t)DM * DUP, DM, DUP, Wup[1], scr, r, lane); continue; } r -= I5;
            if (r < I6) { transpose_item(a.w_down, DFF, DM, Wdn[0], scr, r, lane); continue; } r -= I6;
            transpose_item(a.w_down + (size_t)DFF * DM, DFF, DM, Wdn[1], scr, r, lane);
        }
        norm_rows<0>(a.x, nullptr, a.mix_pre_g, nullptr, nullptr, H, gw, ngw, lane);
    }
    SEAM(0);
    if (IN(1)) GEMM_BF16(H, Wqkv0, SWA_QKV, DM, QKV);
    SEAM(1);
    if (IN(2)) swa_attn_phase(lds, QKV, AO, a.swa_sinks, tid, lane, wave);
    SEAM(2);
    if (IN(3)) GEMM_BF16(AO, Wo0, DM, DM, MO);
    SEAM(3);
    if (IN(4)) norm_rows<1>(a.x, MO, a.mix_post_g, a.ffn_pre_g, a.out, H, gw, ngw, lane);
    SEAM(4);
#define FFN_PHASES(P, L) \
    if (IN(P)) { pg8::Gemm g{(const pg8::bf16_t*)H, (const pg8::bf16_t*)Wup[L], MTOK, DUP, DM}; pg8::StaticOrder S; S.init(MTOK, DUP, G, (int)blockIdx.x); EpiUp E{UG, UV, HALO}; \
        pg8::gemm_phase<EpiUp, pg8::StaticOrder, PG8_ALIGN, PG8_SP2>(lds, g, S, E); } \
    SEAM(P); \
    if (IN((P) + 1)) conv_gelu_phase(UG, UV, HALO, a.conv_w + (size_t)(L) * 3 * DUP, a.conv_b + (size_t)(L) * DUP, blockIdx.x * NTHREADS + tid, G * NTHREADS); \
    SEAM((P) + 1); \
    if (IN((P) + 2)) GEMM_BF16(UG, Wdn[L], DM, DFF, MO); \
    SEAM((P) + 2);
    FFN_PHASES(5, 0)
    if (IN(8)) norm_rows<1>(a.out, MO, a.ffn_post_g, a.mix_pre_g + DM, a.out, H, gw, ngw, lane);
    SEAM(8);
    if (IN(9)) GEMM_BF16(H, Wqkv1, DIFF_QKV, DM, QKV);
    SEAM(9);
    if (IN(10)) diff_attn_phase(lds, QKV, AO, a.lq1, a.lk1, a.lq2, a.lk2, a.subln_g, tid, lane, wave);
    SEAM(10);
    if (IN(11)) GEMM_BF16(AO, Wo1, DM, DM, MO);
    SEAM(11);
    if (IN(12)) norm_rows<1>(a.out, MO, a.mix_post_g + DM, a.ffn_pre_g + DM, a.out, H, gw, ngw, lane);
    SEAM(12);
    FFN_PHASES(13, 1)
    if (IN(16)) norm_rows<1>(a.out, MO, a.ffn_post_g + DM, nullptr, a.out, H, gw, ngw, lane);
#undef IN
#undef SEAM
}

#ifndef MK_PER_PHASE
#define MK_PER_PHASE 0
#endif
constexpr int NPHASES = 17;

extern "C" void kernel_launch(void* const* d_in, const int* in_sizes, int n_in, void* d_out, int out_size, void* d_ws, size_t ws_size, hipStream_t stream) {
    static int grid = 0;
    if (grid == 0) {
        if (n_in != 19 || in_sizes[0] != MTOK * DM || out_size != MTOK * DM || ws_size < WS_END) {
            fprintf(stderr, "kernel_launch: unexpected sizes n_in %d in0 %d out %d ws %zu (need %zu)\n", n_in, n_in > 0 ? in_sizes[0] : -1, out_size, ws_size, (size_t)WS_END); grid = -1; return; }
        int dev = 0, cus = 0, per_cu = 0;
        (void)hipGetDevice(&dev); (void)hipDeviceGetAttribute(&cus, hipDeviceAttributeMultiprocessorCount, dev);
        if (hipFuncSetAttribute((const void*)hybrid_fwd, hipFuncAttributeMaxDynamicSharedMemorySize, LDS_BYTES) != hipSuccess) { fprintf(stderr, "kernel_launch: hipFuncSetAttribute failed\n"); grid = -1; return; }
        if (hipOccupancyMaxActiveBlocksPerMultiprocessor(&per_cu, (const void*)hybrid_fwd, NTHREADS, LDS_BYTES) != hipSuccess || per_cu < 1) { fprintf(stderr, "kernel_launch: occupancy query says %d\n", per_cu); per_cu = 1; }
        (void)hipGetLastError();
        grid = cus * 1;
        if (grid <= 0) grid = 256;
    }
    if (grid < 0) return;
    if (hipMemsetAsync((char*)d_ws + WS_CTL, 0, CTL_BYTES, stream) != hipSuccess) { fprintf(stderr, "kernel_launch: memset failed\n"); return; }
    Args a{};
    a.x = (const float*)d_in[0]; a.mix_pre_g = (const float*)d_in[1]; a.mix_post_g = (const float*)d_in[2]; a.ffn_pre_g = (const float*)d_in[3]; a.ffn_post_g = (const float*)d_in[4];
    a.swa_w_qkv = (const float*)d_in[5]; a.swa_sinks = (const float*)d_in[6]; a.swa_w_o = (const float*)d_in[7];
    a.diff_w_qkv = (const float*)d_in[8]; a.lq1 = (const float*)d_in[9]; a.lk1 = (const float*)d_in[10]; a.lq2 = (const float*)d_in[11]; a.lk2 = (const float*)d_in[12];
    a.subln_g = (const float*)d_in[13]; a.diff_w_o = (const float*)d_in[14];
    a.w_up = (const float*)d_in[15]; a.conv_w = (const float*)d_in[16]; a.conv_b = (const float*)d_in[17]; a.w_down = (const float*)d_in[18];
    a.out = (float*)d_out; a.ws = (unsigned char*)d_ws;
#if MK_PER_PHASE
    for (int p = 0; p < NPHASES; ++p) { a.ph_lo = p; a.ph_hi = p + 1; hipLaunchKernelGGL(hybrid_fwd, dim3(grid), dim3(NTHREADS), LDS_BYTES, stream, a); }
#else
    a.ph_lo = 0; a.ph_hi = NPHASES;
    void* args[] = {&a};
    hipError_t e = hipLaunchCooperativeKernel((const void*)hybrid_fwd, dim3(grid), dim3(NTHREADS), args, LDS_BYTES, stream);
    if (e != hipSuccess) fprintf(stderr, "kernel_launch: cooperative launch failed: %s (grid %d)\n", hipGetErrorString(e), grid);
#endif
}
```
